# Optimizing an MI355X kernel written in HIP

```python
import jax, jax.numpy as jnp
from jax import lax
import numpy as np

D_MODEL = 1024
BATCH = 8
SEQ = 4096
DEPTH = 2

GRID_W = 64
CTX_LEN = 256
BRANCH = 256
MIX_WIDTH = 4 * BRANCH
CONV_K = 3
ATT_HEADS = 4
ATT_KV_HEADS = 2
HEAD_DIM = 64
ROPE_THETA = 10000.0
Q_BLOCK = 128
HG_HEADS = 4
HG_DK = BRANCH // HG_HEADS
HG_DV = BRANCH // HG_HEADS
HG_CHUNK = 64
FN_GROUPS = 4
FN_DIM = BRANCH // FN_GROUPS
EPS = 1e-6

IN_SPLITS = (256, 256, 256, 256,
             256, 128, 128, 256,
             256, 256, 256, 256, 256,
             256, 256)
IN_COLS = 3584

kernel_name = "hybrid_parallel_groups_flow_backbone"


def rms_norm(x, g):
    xf = x.astype(jnp.float32)
    y = xf * lax.rsqrt(jnp.mean(xf * xf, axis=-1, keepdims=True) + EPS)
    return (y * g.astype(jnp.float32)).astype(x.dtype)


def split_cols(t):
    points = [int(p) for p in np.cumsum(IN_SPLITS)[:-1]]
    return jnp.split(t, points, axis=-1)


def axial_rope_tables(rows, dtype):
    r, cidx = jnp.meshgrid(jnp.arange(rows), jnp.arange(GRID_W), indexing="ij")
    r = r.reshape(-1).astype(jnp.float32)
    cidx = cidx.reshape(-1).astype(jnp.float32)
    n_pairs = HEAD_DIM // 4
    freqs = ROPE_THETA ** (-jnp.arange(n_pairs, dtype=jnp.float32) / n_pairs)
    ang = jnp.concatenate([r[:, None] * freqs, cidx[:, None] * freqs], axis=-1)
    return jnp.cos(ang).astype(dtype), jnp.sin(ang).astype(dtype)


def apply_rope(x, cos, sin):
    x1, x2 = x[..., 0::2], x[..., 1::2]
    return jnp.stack([x1 * cos - x2 * sin, x1 * sin + x2 * cos], axis=-1).reshape(x.shape)


def to_heads(t, n_heads):
    b, n, _ = t.shape
    return t.reshape(b, n, n_heads, -1).transpose(0, 2, 1, 3)


def from_heads(t):
    b, h, n, d = t.shape
    return t.transpose(0, 2, 1, 3).reshape(b, n, h * d)


def short_conv(u, w):
    up = jnp.pad(u, ((0, 0), (1, 1), (0, 0)))
    return up[:, :-2] * w[0] + up[:, 1:-1] * w[1] + up[:, 2:] * w[2]


def attend(qb, k, v):
    s = jnp.einsum("bhgqd,bhkd->bhgqk", qb, k).astype(jnp.float32) * (HEAD_DIM ** -0.5)
    p = jax.nn.softmax(s, axis=-1).astype(v.dtype)
    return jnp.einsum("bhgqk,bhkd->bhgqd", p, v)


def gqa_branch(q_l, k_l, v_l, q_c, k_c, v_c, q_g, k_g, cos, sin, need_ctx):
    b, n, _ = q_l.shape
    g = ATT_HEADS // ATT_KV_HEADS
    ql = apply_rope(rms_norm(to_heads(q_l, ATT_HEADS), q_g), cos, sin)
    kl = apply_rope(rms_norm(to_heads(k_l, ATT_KV_HEADS), k_g), cos, sin)
    vl = to_heads(v_l, ATT_KV_HEADS)
    kc = rms_norm(to_heads(k_c, ATT_KV_HEADS), k_g)
    vc = to_heads(v_c, ATT_KV_HEADS)
    k_all = jnp.concatenate([kl, kc], axis=2)
    v_all = jnp.concatenate([vl, vc], axis=2)
    nb = n // Q_BLOCK
    qb = ql.reshape(b, ATT_KV_HEADS, g, nb, Q_BLOCK, HEAD_DIM).transpose(3, 0, 1, 2, 4, 5)
    ob = lax.map(lambda blk: attend(blk, k_all, v_all), qb)
    o_lat = ob.transpose(1, 0, 4, 2, 3, 5).reshape(b, n, ATT_HEADS * HEAD_DIM)
    o_ctx = None
    if need_ctx:
        nc = q_c.shape[1]
        qc = rms_norm(to_heads(q_c, ATT_HEADS), q_g).reshape(b, ATT_KV_HEADS, g, nc, HEAD_DIM)
        oc = attend(qc, kc, vc)
        o_ctx = oc.transpose(0, 3, 1, 2, 4).reshape(b, nc, ATT_HEADS * HEAD_DIM)
    return o_lat, o_ctx


def hgrn_lower_bounds(lb_param):
    p = jax.nn.softmax(lb_param.astype(jnp.float32), axis=1)
    cs = jnp.cumsum(p, axis=1)
    return cs - cs[:, :1]


def hgrn_gates(fx, lb):
    fx = fx.astype(jnp.float32)
    log_f = jnp.logaddexp(jnp.log(lb), jnp.log1p(-lb) + jax.nn.log_sigmoid(fx))
    k = (1.0 - lb) * jax.nn.sigmoid(-fx)
    return log_f, k


def hgrn_scan(q, k, v, log_f, s0, with_output):
    b, h, t, _ = q.shape
    n = t // HG_CHUNK

    def chunks(a):
        return a.astype(jnp.float32).reshape(b, h, n, HG_CHUNK, a.shape[-1]).transpose(2, 0, 1, 3, 4)

    causal = jnp.tril(jnp.ones((HG_CHUNK, HG_CHUNK), dtype=bool))[:, :, None]

    def step(state, inp):
        qc, kc, vc, lf = inp
        a = jnp.cumsum(lf, axis=2)
        a_last = a[:, :, -1:, :]
        s_new = jnp.exp(a_last)[:, :, 0, :, None] * state + jnp.einsum(
            "bhsk,bhsv->bhkv", kc * jnp.exp(a_last - a), vc)
        if not with_output:
            return s_new, None
        inter = jnp.einsum("bhtk,bhkv->bhtv", qc * jnp.exp(a), state)
        diff = a[:, :, :, None, :] - a[:, :, None, :, :]
        dec = jnp.exp(jnp.where(causal, diff, -jnp.inf))
        scores = jnp.einsum("bhtk,bhsk,bhtsk->bhts", qc, kc, dec)
        intra = jnp.einsum("bhts,bhsv->bhtv", scores, vc)
        return s_new, inter + intra

    s_fin, out = lax.scan(step, s0, (chunks(q), chunks(k), chunks(v), chunks(log_f)))
    if with_output:
        out = out.transpose(1, 2, 0, 3, 4).reshape(b, h, t, v.shape[-1])
    return s_fin, out


def hgrn_branch(q_l, ff_l, fb_l, i_l, q_c, ff_c, fb_c, i_c, lb, hg_g, need_ctx):
    b = q_l.shape[0]
    ql = to_heads(jax.nn.silu(q_l), HG_HEADS)
    il = to_heads(i_l, HG_HEADS)
    qc = to_heads(jax.nn.silu(q_c), HG_HEADS)
    ic = to_heads(i_c, HG_HEADS)
    o_lat, o_ctx = 0.0, 0.0
    for d, (f_l, f_c) in enumerate(((ff_l, ff_c), (fb_l, fb_c))):
        flip = (lambda a: a[:, :, ::-1]) if d == 1 else (lambda a: a)
        logf_l, k_l = hgrn_gates(f_l, lb[d])
        logf_c, k_c = hgrn_gates(f_c, lb[d])
        s0 = jnp.zeros((b, HG_HEADS, HG_DK, HG_DV), jnp.float32)
        s_ctx, oc = hgrn_scan(flip(qc), flip(to_heads(k_c, HG_HEADS)), flip(ic),
                              flip(to_heads(logf_c, HG_HEADS)), s0, need_ctx)
        _, ol = hgrn_scan(flip(ql), flip(to_heads(k_l, HG_HEADS)), flip(il),
                          flip(to_heads(logf_l, HG_HEADS)), s_ctx, True)
        o_lat = o_lat + flip(ol)
        if need_ctx:
            o_ctx = o_ctx + flip(oc)
    gain = hg_g.reshape(HG_HEADS, 1, HG_DV)
    out_l = from_heads(rms_norm(o_lat, gain)).astype(q_l.dtype)
    out_c = from_heads(rms_norm(o_ctx, gain)).astype(q_l.dtype) if need_ctx else None
    return out_l, out_c


def fourier_mix(u):
    b, t, _ = u.shape
    uf = u.astype(jnp.float32).reshape(b, t, FN_GROUPS, FN_DIM)
    y = jnp.fft.fft2(uf, axes=(1, 3), norm="ortho").real
    return y.reshape(b, t, BRANCH).astype(u.dtype)


def mix_stream(parts, conv_w):
    cb, cc, cv, cz, _, _, _, az, _, _, _, _, hz, fu, fz = parts
    y_conv = cb * short_conv(cc * cv, conv_w) * jax.nn.silu(cz)
    y_four = fourier_mix(fu) * jax.nn.silu(fz)
    return y_conv, y_four, jax.nn.silu(az), jax.nn.silu(hz)


def hybrid_layer(h, hc, c_act, cc_act, norm_g, w_mod, b_mod, w_in, conv_w, q_g, k_g, lb, hg_g,
                 w_out, cos, sin, need_ctx):
    shift, scale, gate = jnp.split((c_act @ w_mod + b_mod)[:, None, :], 3, axis=-1)
    shift_c, scale_c, gate_c = jnp.split(cc_act @ w_mod + b_mod, 3, axis=-1)
    lat = split_cols((rms_norm(h, norm_g) * (1.0 + scale) + shift) @ w_in)
    cx = split_cols((rms_norm(hc, norm_g) * (1.0 + scale_c) + shift_c) @ w_in)

    att_l, att_c = gqa_branch(lat[4], lat[5], lat[6], cx[4], cx[5], cx[6], q_g, k_g, cos, sin, need_ctx)
    hg_l, hg_c = hgrn_branch(lat[8], lat[9], lat[10], lat[11], cx[8], cx[9], cx[10], cx[11],
                             lb, hg_g, need_ctx)

    y_conv, y_four, g_att, g_hg = mix_stream(lat, conv_w)
    y = jnp.concatenate([y_conv, att_l * g_att, hg_l * g_hg, y_four], axis=-1) @ w_out
    h_new = h + gate * y
    hc_new = None
    if need_ctx:
        yc_conv, yc_four, gc_att, gc_hg = mix_stream(cx, conv_w)
        yc = jnp.concatenate([yc_conv, att_c * gc_att, hg_c * gc_hg, yc_four], axis=-1) @ w_out
        hc_new = hc + gate_c * yc
    return h_new, hc_new


def setup_inputs(seed: int = 0) -> dict:
    key = jax.random.key(seed)
    ks = jax.random.split(key, 16)
    f32 = jnp.float32
    nrm = lambda k, shape: jax.random.normal(k, shape, f32)
    return {
        "x": nrm(ks[0], (BATCH, SEQ, D_MODEL)),
        "c": nrm(ks[1], (BATCH, D_MODEL)),
        "ctx": nrm(ks[2], (BATCH, CTX_LEN, D_MODEL)),
        "c_ctx": nrm(ks[3], (D_MODEL,)),
        "norm_g": 1.0 + 0.1 * nrm(ks[4], (DEPTH, D_MODEL)),
        "w_mod": nrm(ks[5], (DEPTH, D_MODEL, 3 * D_MODEL)) * (0.5 * D_MODEL ** -0.5),
        "b_mod": 0.02 * nrm(ks[6], (DEPTH, 3 * D_MODEL)),
        "w_in": nrm(ks[7], (DEPTH, D_MODEL, IN_COLS)) * (D_MODEL ** -0.5),
        "conv_w": nrm(ks[8], (DEPTH, CONV_K, BRANCH)) * (CONV_K ** -0.5),
        "q_norm_g": 1.0 + 0.1 * nrm(ks[9], (DEPTH, HEAD_DIM)),
        "k_norm_g": 1.0 + 0.1 * nrm(ks[10], (DEPTH, HEAD_DIM)),
        "hgrn_lb": nrm(ks[11], (2, DEPTH, BRANCH)),
        "hgrn_norm_g": 1.0 + 0.1 * nrm(ks[12], (DEPTH, BRANCH)),
        "w_out": nrm(ks[13], (DEPTH, MIX_WIDTH, D_MODEL)) * (MIX_WIDTH ** -0.5),
        "final_g": 1.0 + 0.1 * nrm(ks[14], (D_MODEL,)),
    }


def reference(x, c, ctx, c_ctx, norm_g, w_mod, b_mod, w_in, conv_w, q_norm_g, k_norm_g,
              hgrn_lb, hgrn_norm_g, w_out, final_g):
    rows = x.shape[1] // GRID_W
    cos, sin = axial_rope_tables(rows, x.dtype)
    lb_all = hgrn_lower_bounds(hgrn_lb)
    c_act = jax.nn.silu(c)
    cc_act = jax.nn.silu(c_ctx)
    h, hc = x, ctx
    for layer in range(DEPTH):
        h, hc = hybrid_layer(h, hc, c_act, cc_act, norm_g[layer], w_mod[layer], b_mod[layer],
                             w_in[layer], conv_w[layer], q_norm_g[layer], k_norm_g[layer],
                             lb_all[:, layer], hgrn_norm_g[layer], w_out[layer], cos, sin,
                             need_ctx=layer < DEPTH - 1)
    return rms_norm(h, final_g)
```

```cpp
#include <hip/hip_runtime.h>
#include <hip/hip_cooperative_groups.h>
#include <cstdio>
namespace cg = cooperative_groups;
#ifndef MK_PER_PHASE
#define MK_PER_PHASE 0
#endif
namespace pg8 {
#define PG8_LAS __attribute__((address_space(3)))
typedef unsigned short bf16_t;
typedef short bf16x8 __attribute__((ext_vector_type(8)));
typedef float f32x4 __attribute__((ext_vector_type(4)));
typedef unsigned u32x4 __attribute__((ext_vector_type(4)));
constexpr int BM = 256, BK = 64, HALF = 128, HTB = HALF * BK * 2  , STAGE_BYTES = 8 * HTB, NXCD = 8, WGM = 8;

__host__ __device__ __forceinline__ int lds_byte(int r, int c) { const int st = (r >> 4) * 2 + (c >> 5), rr = r & 15, cc = c & 31, ob = rr * 64 + cc * 2; return st * 1024 + (ob ^ (((ob >> 9) & 1) << 5)); }
__host__ __device__ __forceinline__ void stage_rc(int b, int& R, int& C) { const int st = b / 1024, sb = b % 1024, swz = sb ^ (((sb >> 9) & 1) << 5); R = (st >> 1) * 16 + swz / 64; C = (st & 1) * 32 + (swz % 64) / 2; }
__host__ __device__ __forceinline__ int perm32(int rho) { const int n = rho >> 4, i = rho & 15; return 8 * (i >> 2) + 4 * n + (i & 3); }

struct Unit { int pm, pn; };
struct Gemm { const bf16_t* A; const bf16_t* Bt; int M, N, K; };

struct StaticOrder {
    int nM, nN, nwg, G, c;
    __host__ __device__ void init(int M, int N, int G_, int c_) { nM = M / BM; nN = N / BM; nwg = nM * nN; G = G_; c = c_; }
    __host__ __device__ bool next(int i, Unit& u) const {
        const long L = (long)i * G + c; if (L >= nwg) return false;
        int wgid = (int)L; { const int q = nwg / NXCD, r = nwg % NXCD, xcd = wgid % NXCD, off = wgid / NXCD; wgid = (xcd < r ? xcd * (q + 1) : r * (q + 1) + (xcd - r) * q) + off; }
        const int nig = WGM * nN, gid = wgid / nig, fm = gid * WGM, gsz = (nM - fm) < WGM ? (nM - fm) : WGM;
        u.pm = fm + ((wgid % nig) % gsz); u.pn = (wgid % nig) / gsz; return true;
    }
    __device__ __forceinline__ void a_ready(const Unit&) const {}
    __device__ __forceinline__ void done(const Unit&) const {}
};

__device__ __forceinline__ unsigned cvt_pk_bf16(float lo, float hi) { unsigned r; asm volatile("v_cvt_pk_bf16_f32 %0, %1, %2" : "=v"(r) : "v"(lo), "v"(hi)); return r; }
typedef float f32x2 __attribute__((ext_vector_type(2)));
__device__ __forceinline__ f32x2 gelu_pk(f32x2 v) {
    const f32x2 av = __builtin_elementwise_abs(v), d = av * 0.2316418882f + 1.0f;
    f32x2 t; t.x = __builtin_amdgcn_rcpf(d.x); t.y = __builtin_amdgcn_rcpf(d.y);
    f32x2 q = t * 0.5307027145f + (-0.7265760135f); q = q * t + 0.7107068705f; q = q * t + (-0.142248368f); q = q * t + 0.127414796f; q = q * t;
    const f32x2 s = (v * v) * (-0.72134752044f);
    f32x2 e; e.x = __builtin_amdgcn_exp2f(s.x); e.y = __builtin_amdgcn_exp2f(s.y);
    const f32x2 m = v * (q * e), r = v - m;
    f32x2 o; o.x = v.x < 0.f ? m.x : r.x; o.y = v.y < 0.f ? m.y : r.y; return o;
}

struct EpiF32 {
    static constexpr bool PERM = false, AFTER_DRAIN = false, MID = false;
    float* C; int ldc; const float* bias;
    __device__ __forceinline__ void operator()(const f32x4 (&acc)[2][2][4][2], const Unit& u, int wr, int wc, int fr, int fq) const {
        const int row0 = u.pm * BM + wr * 64 + fr, col0 = u.pn * BM + wc * 32 + 4 * fq;
        f32x4 bv[2][2];
#pragma unroll
        for (int bj = 0; bj < 2; ++bj)
#pragma unroll
            for (int n = 0; n < 2; ++n) bv[bj][n] = bias ? *(const f32x4*)(bias + col0 + bj * HALF + n * 16) : (f32x4){0.f, 0.f, 0.f, 0.f};
#pragma unroll
        for (int ai = 0; ai < 2; ++ai)
#pragma unroll
            for (int m = 0; m < 4; ++m) { float* rowp = C + (size_t)(row0 + ai * HALF + m * 16) * ldc + col0;
#pragma unroll
                for (int bj = 0; bj < 2; ++bj)
#pragma unroll
                    for (int n = 0; n < 2; ++n) *(f32x4*)(rowp + bj * HALF + n * 16) = acc[ai][bj][m][n] + bv[bj][n]; }
    }
};
template <int ACT  > struct EpiBf16 {
    static constexpr bool PERM = true, AFTER_DRAIN = false, MID = false;
    bf16_t* O; int ldc; const float* bias; int split_cols; size_t split_stride;
    __device__ __forceinline__ void operator()(const f32x4 (&acc)[2][2][4][2], const Unit& u, int wr, int wc, int fr, int fq) const {
        const int row0 = u.pm * BM + wr * 64 + fr; int colt = u.pn * BM; bf16_t* base = O;
        if (split_cols) { const int t = colt / split_cols; base += (size_t)t * split_stride; colt -= t * split_cols; }
        const int col0 = colt + wc * 32 + 8 * fq, bcol0 = u.pn * BM + wc * 32 + 8 * fq;
        f32x4 bv[2][2];
#pragma unroll
        for (int bj = 0; bj < 2; ++bj)
#pragma unroll
            for (int n = 0; n < 2; ++n) bv[bj][n] = bias ? *(const f32x4*)(bias + bcol0 + bj * HALF + 4 * n) : (f32x4){0.f, 0.f, 0.f, 0.f};
#pragma unroll
        for (int ai = 0; ai < 2; ++ai)
#pragma unroll
            for (int m = 0; m < 4; ++m) { bf16_t* rowp = base + (size_t)(row0 + ai * HALF + m * 16) * ldc + col0;
#pragma unroll
                for (int bj = 0; bj < 2; ++bj) { f32x4 v0 = acc[ai][bj][m][0] + bv[bj][0], v1 = acc[ai][bj][m][1] + bv[bj][1];
                    if (ACT == 1) { f32x2 a = gelu_pk((f32x2){v0[0], v0[1]}), b = gelu_pk((f32x2){v0[2], v0[3]}), c = gelu_pk((f32x2){v1[0], v1[1]}), d = gelu_pk((f32x2){v1[2], v1[3]});
                        v0 = (f32x4){a.x, a.y, b.x, b.y}; v1 = (f32x4){c.x, c.y, d.x, d.y}; }
                    if (ACT == 2) {
#pragma unroll
                        for (int j = 0; j < 4; ++j) { v0[j] = 0.5f * v0[j] * (1.0f + erff(v0[j] * 0.70710678f)); v1[j] = 0.5f * v1[j] * (1.0f + erff(v1[j] * 0.70710678f)); } }
                    u32x4 w; w.x = cvt_pk_bf16(v0[0], v0[1]); w.y = cvt_pk_bf16(v0[2], v0[3]); w.z = cvt_pk_bf16(v1[0], v1[1]); w.w = cvt_pk_bf16(v1[2], v1[3]);
                    *(u32x4*)(rowp + bj * HALF) = w; } }
    }
};
template <class Epi, class Sched>
__device__ __forceinline__ void gemm_phase(PG8_LAS unsigned char* lds, const Gemm g, const Sched& S, const Epi& E) {
    int tid_l = threadIdx.x; asm volatile("" : "+v"(tid_l));
    const int tid = tid_l, wid = __builtin_amdgcn_readfirstlane(tid >> 6), lane = tid & 63, wr = wid >> 2, wc = wid & 3, fr = lane & 15, fq = lane >> 4;
    const int K = g.K, nt = K / BK;
    unsigned voffA[2], voffB[2];
#pragma unroll
    for (int i = 0; i < 2; ++i) { int R, C; stage_rc(tid * 16 + i * 8192, R, C); const int Rb = Epi::PERM ? ((R & ~31) + perm32(R & 31)) : R;
        voffA[i] = (unsigned)(R * K + C) * 2u; voffB[i] = (unsigned)(Rb * K + C) * 2u; }
    const size_t kstep = (size_t)(BK * 2);
    const size_t hstep = (size_t)HALF * K * 2;
    const size_t tstep = 2 * hstep;
    const unsigned ldsw = (unsigned)wid * 1024u;
    const int aoff = lds_byte(wr * 64 + fr, fq * 8), boff = lds_byte(wc * 32 + fr, fq * 8);
#define PG8_SA(b, h) (((b) * 2 + (h)) * HTB)
#define PG8_SB(b, h) ((4 + (b) * 2 + (h)) * HTB)
#define PG8_STAGE(bufoff, gbase, voff) do { _Pragma("unroll") for (int _i = 0; _i < 2; ++_i) \
        __builtin_amdgcn_global_load_lds((const unsigned*)((const char*)(gbase) + (voff)[_i]), (PG8_LAS unsigned*)(lds + (bufoff) + ldsw + _i * 8192), 16, 0, 0); } while (0)
#define PG8_LDA(dst, b, h) do { _Pragma("unroll") for (int m = 0; m < 4; ++m) _Pragma("unroll") for (int k = 0; k < 2; ++k) dst[m][k] = *(const PG8_LAS bf16x8*)(lds + PG8_SA(b, h) + aoff + m * 2048 + k * 1024); } while (0)
#define PG8_LDB(dst, b, h) do { _Pragma("unroll") for (int n = 0; n < 2; ++n) _Pragma("unroll") for (int k = 0; k < 2; ++k) dst[n][k] = *(const PG8_LAS bf16x8*)(lds + PG8_SB(b, h) + boff + n * 2048 + k * 1024); } while (0)
#define PG8_MMA(ai, bj, At, Bt) do { __builtin_amdgcn_s_setprio(1); _Pragma("unroll") for (int m = 0; m < 4; ++m) _Pragma("unroll") for (int n = 0; n < 2; ++n) _Pragma("unroll") for (int k = 0; k < 2; ++k) \
        acc[ai][bj][m][n] = __builtin_amdgcn_mfma_f32_16x16x32_bf16(Bt[n][k], At[m][k], acc[ai][bj][m][n], 0, 0, 0); __builtin_amdgcn_s_setprio(0); } while (0)
#define PG8_WAIT_V(n) asm volatile("s_waitcnt vmcnt(" #n ")" ::: "memory")
#define PG8_WAIT_L(n) asm volatile("s_waitcnt lgkmcnt(" #n ")" ::: "memory")
#define PG8_BAR __builtin_amdgcn_s_barrier()
#define PG8_SCHED __builtin_amdgcn_sched_barrier(0)
    Unit cur, nxt; int ui = 0;
    if (!S.next(0, cur)) return;
    f32x4 acc[2][2][4][2];
#pragma unroll
    for (int a = 0; a < 2; ++a)
#pragma unroll
        for (int b = 0; b < 2; ++b)
#pragma unroll
            for (int m = 0; m < 4; ++m)
#pragma unroll
                for (int n = 0; n < 2; ++n) acc[a][b][m][n] = (f32x4){0.f, 0.f, 0.f, 0.f};
    bf16x8 At[4][2], B0[2][2], B1[2][2];
    const char* cA = (const char*)g.A + (size_t)cur.pm * tstep; const char* cB = (const char*)g.Bt + (size_t)cur.pn * tstep;
    S.a_ready(cur);
    PG8_STAGE(PG8_SB(0, 0), cB, voffB); PG8_STAGE(PG8_SA(0, 0), cA, voffA); PG8_STAGE(PG8_SB(0, 1), cB + hstep, voffB); PG8_STAGE(PG8_SA(0, 1), cA + hstep, voffA);
    if (wr == 1) PG8_BAR;
    PG8_WAIT_V(4); PG8_BAR;
    PG8_STAGE(PG8_SB(1, 0), cB + kstep, voffB); PG8_STAGE(PG8_SA(1, 0), cA + kstep, voffA); PG8_STAGE(PG8_SB(1, 1), cB + hstep + kstep, voffB);
    PG8_WAIT_V(6); PG8_BAR;
    for (;;) {
        const bool has_next = S.next(ui + 1, nxt);
        const char* nA = has_next ? (const char*)g.A + (size_t)nxt.pm * tstep : cA; const char* nB = has_next ? (const char*)g.Bt + (size_t)nxt.pn * tstep : cB;
        for (int t = 0; t < nt; t += 2) {
            if constexpr (Epi::MID) {
                if (t == (nt >> 1)) {
                    E.mid(acc, cur, wr, wc, fr, fq);
#pragma unroll
                    for (int a = 0; a < 2; ++a)
#pragma unroll
                        for (int b = 0; b < 2; ++b)
#pragma unroll
                            for (int m = 0; m < 4; ++m)
#pragma unroll
                                for (int n = 0; n < 2; ++n) acc[a][b][m][n] = (f32x4){0.f, 0.f, 0.f, 0.f};
                }
            }
            const bool last = (t == nt - 2);
            const char* a1 = cA + (size_t)(t + 1) * kstep;
            const char* a2 = last ? nA : cA + (size_t)(t + 2) * kstep; const char* b2 = last ? nB : cB + (size_t)(t + 2) * kstep;
            const char* a3 = a2 + kstep; const char* b3 = b2 + kstep;
            if (last && has_next) S.a_ready(nxt);
            PG8_LDB(B0, 0, 0); PG8_SCHED; PG8_LDA(At, 0, 0); PG8_STAGE(PG8_SA(1, 1), a1 + hstep, voffA);
            PG8_WAIT_L(8); PG8_BAR; PG8_WAIT_L(0); PG8_MMA(0, 0, At, B0); PG8_BAR; PG8_SCHED;
            PG8_LDB(B1, 0, 1); PG8_STAGE(PG8_SB(0, 0), b2, voffB);
            PG8_BAR; PG8_WAIT_L(0); PG8_MMA(0, 1, At, B1); PG8_BAR;
            PG8_LDA(At, 0, 1); PG8_STAGE(PG8_SA(0, 0), a2, voffA);
            PG8_BAR; PG8_WAIT_L(0); PG8_MMA(1, 0, At, B0); PG8_BAR; PG8_SCHED;
            PG8_STAGE(PG8_SB(0, 1), b2 + hstep, voffB);
            PG8_WAIT_V(6); PG8_BAR; PG8_MMA(1, 1, At, B1); PG8_BAR;
            PG8_LDB(B0, 1, 0); PG8_SCHED; PG8_LDA(At, 1, 0); PG8_STAGE(PG8_SA(0, 1), a2 + hstep, voffA);
            PG8_WAIT_L(8); PG8_BAR; PG8_WAIT_L(0); PG8_MMA(0, 0, At, B0); PG8_BAR; PG8_SCHED;
            PG8_LDB(B1, 1, 1); PG8_STAGE(PG8_SB(1, 0), b3, voffB);
            PG8_BAR; PG8_WAIT_L(0); PG8_MMA(0, 1, At, B1); PG8_BAR;
            PG8_LDA(At, 1, 1); PG8_STAGE(PG8_SA(1, 0), a3, voffA);
            PG8_BAR; PG8_WAIT_L(0); PG8_MMA(1, 0, At, B0); PG8_BAR; PG8_SCHED;
            PG8_STAGE(PG8_SB(1, 1), b3 + hstep, voffB);
            PG8_WAIT_V(6); PG8_BAR; PG8_MMA(1, 1, At, B1); PG8_BAR;
        }
        if constexpr (!Epi::AFTER_DRAIN) { E(acc, cur, wr, wc, fr, fq); S.done(cur); }
        if (!has_next) break;
#pragma unroll
        for (int a = 0; a < 2; ++a)
#pragma unroll
            for (int b = 0; b < 2; ++b)
#pragma unroll
                for (int m = 0; m < 4; ++m)
#pragma unroll
                    for (int n = 0; n < 2; ++n) acc[a][b][m][n] = (f32x4){0.f, 0.f, 0.f, 0.f};
        cur = nxt; cA = nA; cB = nB; ++ui;
    }
    PG8_WAIT_V(0);
    if (wr == 0) PG8_BAR;
    PG8_BAR;
    if constexpr (Epi::AFTER_DRAIN) { E.fused(acc, cur, wr, wc, fr, fq, lds, wid, lane); S.done(cur); }
#undef PG8_SA
#undef PG8_SB
#undef PG8_STAGE
#undef PG8_LDA
#undef PG8_LDB
#undef PG8_MMA
#undef PG8_WAIT_V
#undef PG8_WAIT_L
#undef PG8_BAR
#undef PG8_SCHED
}
}
#define XB_TMO      128
#define XB_XCNT(j)  (256  + 64 * (j))
#define XB_XSUB(j)  (1280 + 64 * (j))
#define XB_XGEN(j)  (2304 + 64 * (j))
#define XB_TOP      3328
#define XB_TOPGEN   3392
#define XCD_BAR_WORDS 3456
#define XB_SPIN_CAP (1u << 18)
#define LAS __attribute__((address_space(3)))

__device__ __forceinline__ unsigned xb_ld(unsigned* p)              { return __hip_atomic_load(p, __ATOMIC_RELAXED, __HIP_MEMORY_SCOPE_AGENT); }
__device__ __forceinline__ unsigned xb_add(unsigned* p, unsigned v) { return __hip_atomic_fetch_add(p, v, __ATOMIC_RELAXED, __HIP_MEMORY_SCOPE_AGENT); }
__device__ __forceinline__ unsigned xb_xcc_id() { return (unsigned)__builtin_amdgcn_s_getreg((3 << 11) | 20) & 0xFu; }
#define XB_SPIN(cond, bar) do { unsigned _sp = 0; while (cond) { __builtin_amdgcn_s_sleep(1); \
    if ((++_sp & 255u) == 0u) { if (xb_ld(&(bar)[XB_TMO])) break; if (_sp > XB_SPIN_CAP) { atomicAdd(&(bar)[XB_TMO], 1u); break; } } } } while (0)

struct XcdBarrier {
    unsigned* bar; unsigned x;
    volatile LAS unsigned* st;
};

__device__ __forceinline__ XcdBarrier xcd_barrier_post(unsigned* bar, volatile LAS unsigned* st) {
    XcdBarrier b; b.bar = bar; b.x = xb_xcc_id(); b.st = st;
    if (threadIdx.x == 0) (void)xb_add(&bar[XB_XCNT(b.x)], 1u);
    return b;
}
__device__ __forceinline__ void xcd_barrier_complete(unsigned* bar, unsigned x, unsigned& nloc, unsigned& nx) {
    const unsigned G = gridDim.x * gridDim.y * gridDim.z;
    unsigned sum, cnt, mine, sp = 0u;
    for (;;) {
        sum = 0u; cnt = 0u; mine = 0u;
#pragma unroll
        for (unsigned j = 0; j < 16; ++j) { const unsigned c = xb_ld(&bar[XB_XCNT(j)]); sum += c; cnt += (c > 0u) ? 1u : 0u; mine = (j == x) ? c : mine; }
        if (sum == G) break;
        __builtin_amdgcn_s_sleep(1);
        if ((++sp & 255u) == 0u) { if (xb_ld(&bar[XB_TMO])) break; if (sp > XB_SPIN_CAP) { atomicAdd(&bar[XB_TMO], 1u); break; } }
    }
    nloc = mine > 0u ? mine : 1u; nx = cnt > 0u ? cnt : 1u;
}

__device__ __forceinline__ void xcd_barrier(const XcdBarrier& b) {
    asm volatile("s_waitcnt vmcnt(0)" ::: "memory");
    __syncthreads();
    if (threadIdx.x == 0) {
        unsigned* bar = b.bar;
        __builtin_amdgcn_s_waitcnt(0);
        unsigned nloc = b.st[0], nx = b.st[1];
        if (nloc == 0u) { xcd_barrier_complete(bar, b.x, nloc, nx); b.st[0] = nloc; b.st[1] = nx; }
        const unsigned old = xb_add(&bar[XB_XSUB(b.x)], 1u);
        const unsigned gen = old / nloc;
        if (old + 1u == (gen + 1u) * nloc) {
            __builtin_amdgcn_fence(__ATOMIC_RELEASE, "agent");
            asm volatile("s_waitcnt vmcnt(0)" ::: "memory");
            const unsigned og = xb_add(&bar[XB_TOP], 1u);
            const unsigned tg = og / nx;
            if (og + 1u == (tg + 1u) * nx) xb_add(&bar[XB_TOPGEN], 1u);
            else XB_SPIN(xb_ld(&bar[XB_TOPGEN]) == tg, bar);
            __builtin_amdgcn_fence(__ATOMIC_ACQUIRE, "agent");
            xb_add(&bar[XB_XGEN(b.x)], 1u);
            asm volatile("s_waitcnt vmcnt(0)" ::: "memory");
        } else {
            XB_SPIN(xb_ld(&bar[XB_XGEN(b.x)]) == gen, bar);
            __builtin_amdgcn_fence(__ATOMIC_ACQUIRE, "agent");
            asm volatile("s_waitcnt vmcnt(0)" ::: "memory");
        }
    }
    __syncthreads();
}


#define DI __device__ __forceinline__
typedef unsigned short u16;
typedef short bf16x8 __attribute__((ext_vector_type(8)));
typedef short s16x4 __attribute__((ext_vector_type(4)));
typedef float f32x2v __attribute__((ext_vector_type(2)));
typedef float f32x4 __attribute__((ext_vector_type(4)));
typedef float f32x16 __attribute__((ext_vector_type(16)));
typedef unsigned u32x4 __attribute__((ext_vector_type(4)));
typedef unsigned u32x2 __attribute__((ext_vector_type(2)));
typedef __bf16 bf16x2n __attribute__((ext_vector_type(2)));
#define ST(p) (DRY ? (decltype(p))(dummy + (size_t)tid * 16) : (p))
#define MFMA32(a, b, c) __builtin_amdgcn_mfma_f32_32x32x16_bf16((a), (b), (c), 0, 0, 0)

constexpr int DM = 1024, NB = 8, SEQ = 4096, CTXL = 256, NLAT = NB * SEQ, NCTX = NB * CTXL, NROW = NLAT + NCTX, INC = 3584;
constexpr int NKEY = SEQ + CTXL, NCHUNK = NROW / 64, FK = 4096, FKC = 512;
constexpr float EPSV = 1e-6f;
constexpr float QSCALE = 0.125f * 1.4426950408889634f;
constexpr int C_CB = 0, C_CC = 256, C_CX = 512, C_CZ = 768, C_AQ = 1024, C_AK = 1280, C_AV = 1408, C_AZ = 1536,
              C_HQ = 1792, C_HF0 = 2048, C_HF1 = 2304, C_HI = 2560, C_HZ = 2816, C_FU = 3072, C_FZ = 3328;

constexpr size_t al256(size_t x) { return (x + 255) & ~(size_t)255; }
constexpr size_t WS_CTR = 0;
constexpr size_t WS_BAR = 4096;
constexpr size_t WS_CTL_BYTES = 32768;
constexpr size_t WS_E = WS_CTL_BYTES;
constexpr size_t WS_MOD = WS_E + 8192;
constexpr size_t WS_ROPE = WS_MOD + al256((size_t)2 * 9 * 3072 * 4);
constexpr size_t WS_WIN = WS_ROPE + (size_t)4096 * 32 * 2 * 4;
constexpr size_t WS_WOUT = WS_WIN + (size_t)2 * INC * DM * 2;
constexpr size_t WS_CS = WS_WOUT + (size_t)2 * DM * DM * 2;
constexpr size_t WS_CSC = WS_CS + (size_t)SEQ * FK * 2;
constexpr size_t WS_UT = WS_CSC + (size_t)CTXL * FKC * 2;
constexpr size_t WS_UTC = WS_UT + (size_t)2048 * FK * 2;
constexpr size_t WS_VT = WS_UTC + (size_t)2048 * FKC * 2;
constexpr size_t WS_G = WS_VT + (size_t)16 * 64 * NKEY * 2;
constexpr size_t WS_DEC = WS_G + (size_t)NCHUNK * 8 * 4096 * 2;
constexpr size_t WS_EREF = WS_DEC + (size_t)NCHUNK * 8 * 64 * 4;
constexpr size_t WS_VTH = WS_EREF + (size_t)NCHUNK * 8 * 64 * 4;
constexpr size_t WS_HC = WS_VTH + (size_t)NCHUNK * 4 * 4096 * 2;
constexpr size_t WS_Y = WS_HC + (size_t)NCTX * DM * 4;
constexpr size_t WS_Z = WS_Y + (size_t)NROW * DM * 2;
constexpr size_t WS_STASH = WS_Z + (size_t)NROW * INC * 2;
constexpr size_t WS_END = WS_STASH + (size_t)64 * 262144;

constexpr int LDS_CTL = 147456;
constexpr int LDS_BYTES = LDS_CTL + 1024;

struct Params {
    const float* x; const float* c; const float* ctx; const float* c_ctx; const float* norm_g; const float* w_mod; const float* b_mod;
    const float* w_in; const float* conv_w; const float* q_g; const float* k_g; const float* hgrn_lb; const float* hg_g; const float* w_out; const float* final_g;
    float* out; unsigned char* ws;
    int ph_lo, ph_hi;
};

DI int tidx() { int t = threadIdx.x; asm volatile("" : "+v"(t)); return t; }
template <class T> DI T* relaunder(T* p) {
    unsigned long long v = (unsigned long long)p;
    asm volatile("" : "+s"(v));
    return (T*)(__attribute__((address_space(1))) T*)v;
}
DI Params launder(Params Q) {
    Q.x = relaunder(Q.x); Q.c = relaunder(Q.c); Q.ctx = relaunder(Q.ctx); Q.c_ctx = relaunder(Q.c_ctx); Q.norm_g = relaunder(Q.norm_g); Q.w_mod = relaunder(Q.w_mod);
    Q.b_mod = relaunder(Q.b_mod); Q.w_in = relaunder(Q.w_in); Q.conv_w = relaunder(Q.conv_w); Q.q_g = relaunder(Q.q_g); Q.k_g = relaunder(Q.k_g); Q.hgrn_lb = relaunder(Q.hgrn_lb);
    Q.hg_g = relaunder(Q.hg_g); Q.w_out = relaunder(Q.w_out); Q.final_g = relaunder(Q.final_g); Q.out = relaunder(Q.out); Q.ws = relaunder(Q.ws);
    return Q;
}
DI float bf2f(u16 v) { return __uint_as_float((unsigned)v << 16); }
DI float bf2f_s(short v) { return __uint_as_float((unsigned)(u16)v << 16); }
DI unsigned pack2(float lo, float hi) { f32x2v v = {lo, hi}; bf16x2n b = __builtin_convertvector(v, bf16x2n); return __builtin_bit_cast(unsigned, b); }
DI u16 f2bf(float f) { return (u16)(pack2(f, 0.f) & 0xffffu); }
DI bf16x8 ld8(const u16* p) { return *(const bf16x8*)p; }
DI s16x4 ld4(const u16* p) { return *(const s16x4*)p; }
DI float silu_f(float x) { return x * __builtin_amdgcn_rcpf(1.0f + __expf(-x)); }
DI bf16x8 pack8(float a0, float a1, float a2, float a3, float a4, float a5, float a6, float a7) {
    u32x4 p; p.x = pack2(a0, a1); p.y = pack2(a2, a3); p.z = pack2(a4, a5); p.w = pack2(a6, a7); return __builtin_bit_cast(bf16x8, p);
}
DI int crow(int reg, int h) { return (reg & 3) + 8 * (reg >> 2) + 4 * h; }
DI f32x16 zero16() { f32x16 z; for (int i = 0; i < 16; ++i) z[i] = 0.f; return z; }

struct EpiRes {
    static constexpr bool PERM = true, AFTER_DRAIN = false, MID = false;
    const float* src32; const u16* src16; u16* dst; const float* mod; int use16;
    DI void operator()(const pg8::f32x4 (&acc)[2][2][4][2], const pg8::Unit& u, int wr, int wc, int fr, int fq) const {
        const float* gate = mod + (u.pm >> 4) * 3072 + 2048;
        const int row0 = u.pm * 256 + wr * 64 + fr, col0 = u.pn * 256 + wc * 32 + 8 * fq;
        f32x4 gv[2][2];
#pragma unroll
        for (int bj = 0; bj < 2; ++bj)
#pragma unroll
            for (int n = 0; n < 2; ++n) gv[bj][n] = *(const f32x4*)(gate + col0 + bj * 128 + 4 * n);
        if (use16) {
#pragma unroll
            for (int ai = 0; ai < 2; ++ai) {
                bf16x8 t[4][2];
#pragma unroll
                for (int m = 0; m < 4; ++m)
#pragma unroll
                    for (int bj = 0; bj < 2; ++bj) t[m][bj] = ld8(src16 + (size_t)(row0 + ai * 128 + m * 16) * DM + col0 + bj * 128);
#pragma unroll
                for (int m = 0; m < 4; ++m)
#pragma unroll
                    for (int bj = 0; bj < 2; ++bj) {
                        const f32x4 a0 = acc[ai][bj][m][0], a1 = acc[ai][bj][m][1], g0 = gv[bj][0], g1 = gv[bj][1]; const bf16x8 tt = t[m][bj];
                        *(bf16x8*)(dst + (size_t)(row0 + ai * 128 + m * 16) * DM + col0 + bj * 128) =
                            pack8(bf2f_s(tt[0]) + g0[0] * a0[0], bf2f_s(tt[1]) + g0[1] * a0[1], bf2f_s(tt[2]) + g0[2] * a0[2], bf2f_s(tt[3]) + g0[3] * a0[3],
                                  bf2f_s(tt[4]) + g1[0] * a1[0], bf2f_s(tt[5]) + g1[1] * a1[1], bf2f_s(tt[6]) + g1[2] * a1[2], bf2f_s(tt[7]) + g1[3] * a1[3]);
                    }
            }
        } else {
#pragma unroll
            for (int ai = 0; ai < 2; ++ai)
#pragma unroll
                for (int mh = 0; mh < 2; ++mh) {
                    f32x4 r[2][2][2];
#pragma unroll
                    for (int m = 0; m < 2; ++m)
#pragma unroll
                        for (int bj = 0; bj < 2; ++bj)
#pragma unroll
                            for (int n = 0; n < 2; ++n) r[m][bj][n] = *(const f32x4*)(src32 + (size_t)(row0 + ai * 128 + (2 * mh + m) * 16) * DM + col0 + bj * 128 + 4 * n);
#pragma unroll
                    for (int m = 0; m < 2; ++m)
#pragma unroll
                        for (int bj = 0; bj < 2; ++bj) {
                            const f32x4 v0 = r[m][bj][0] + gv[bj][0] * acc[ai][bj][2 * mh + m][0], v1 = r[m][bj][1] + gv[bj][1] * acc[ai][bj][2 * mh + m][1];
                            *(bf16x8*)(dst + (size_t)(row0 + ai * 128 + (2 * mh + m) * 16) * DM + col0 + bj * 128) = pack8(v0[0], v0[1], v0[2], v0[3], v1[0], v1[1], v1[2], v1[3]);
                        }
                }
        }
    }
};
struct EpiFour {
    static constexpr bool PERM = true, AFTER_DRAIN = false, MID = false;
    const u16* Z; u16* Y; int isctx; float scale; const float* E;
    DI void operator()(const pg8::f32x4 (&acc)[2][2][4][2], const pg8::Unit& u, int wr, int wc, int fr, int fq) const {
        const int b = u.pn;
        const int rbase = (isctx ? NLAT + b * CTXL : b * SEQ) + u.pm * 256 + wr * 64 + fr;
        const int ch0 = wc * 32 + 8 * fq;
        const float esg = (fr & 1) ? -1.0f : 1.0f;
        f32x4 e0[2], e1[2];
#pragma unroll
        for (int bj = 0; bj < 2; ++bj) {
            if (E) { e0[bj] = *(const f32x4*)(E + b * 256 + ch0 + bj * 128) * esg; e1[bj] = *(const f32x4*)(E + b * 256 + ch0 + bj * 128 + 4) * esg; }
            else { e0[bj] = (f32x4){0.f, 0.f, 0.f, 0.f}; e1[bj] = e0[bj]; }
        }
#pragma unroll
        for (int ai = 0; ai < 2; ++ai) {
            bf16x8 zz[4][2];
#pragma unroll
            for (int m = 0; m < 4; ++m)
#pragma unroll
                for (int bj = 0; bj < 2; ++bj) zz[m][bj] = ld8(Z + (size_t)(rbase + ai * 128 + m * 16) * INC + C_FZ + ch0 + bj * 128);
#pragma unroll
            for (int m = 0; m < 4; ++m) {
                const size_t row = (size_t)(rbase + ai * 128 + m * 16);
#pragma unroll
                for (int bj = 0; bj < 2; ++bj) {
                    const int ch = ch0 + bj * 128;
                    const bf16x8 z = zz[m][bj];
                    const f32x4 v0 = acc[ai][bj][m][0] + e0[bj], v1 = acc[ai][bj][m][1] + e1[bj];
                    u32x4 w;
                    w.x = pack2(v0[0] * scale * silu_f(bf2f_s(z[0])), v0[1] * scale * silu_f(bf2f_s(z[1])));
                    w.y = pack2(v0[2] * scale * silu_f(bf2f_s(z[2])), v0[3] * scale * silu_f(bf2f_s(z[3])));
                    w.z = pack2(v1[0] * scale * silu_f(bf2f_s(z[4])), v1[1] * scale * silu_f(bf2f_s(z[5])));
                    w.w = pack2(v1[2] * scale * silu_f(bf2f_s(z[6])), v1[3] * scale * silu_f(bf2f_s(z[7])));
                    *(u32x4*)(Y + row * DM + 768 + ch) = w;
                }
            }
        }
    }
};

struct EpiFourM {
    static constexpr bool PERM = true, AFTER_DRAIN = false, MID = true;
    const u16* Z; u16* Y; float scale; const float* E; f32x4* stash;
    DI void mid(const pg8::f32x4 (&acc)[2][2][4][2], const pg8::Unit&, int wr, int wc, int fr, int fq) const {
        f32x4* p = stash + ((wr * 4 + wc) * 64 + fq * 16 + fr);
#pragma unroll
        for (int ai = 0; ai < 2; ++ai)
#pragma unroll
            for (int m = 0; m < 4; ++m)
#pragma unroll
                for (int bj = 0; bj < 2; ++bj)
#pragma unroll
                    for (int n = 0; n < 2; ++n) { *p = acc[ai][bj][m][n]; p += 512; asm volatile("" : "+v"(p)); }
    }
    DI void operator()(const pg8::f32x4 (&acc)[2][2][4][2], const pg8::Unit& u, int wr, int wc, int fr, int fq) const {
        const f32x4* p = stash + ((wr * 4 + wc) * 64 + fq * 16 + fr);
        const int b = u.pn, tp0 = u.pm * 256 + wr * 64 + fr, ch0 = wc * 32 + 8 * fq;
        const float esg = (fr & 1) ? -1.0f : 1.0f;
        f32x4 e0[2], e1[2];
#pragma unroll
        for (int bj = 0; bj < 2; ++bj) { e0[bj] = *(const f32x4*)(E + b * 256 + ch0 + bj * 128) * esg; e1[bj] = *(const f32x4*)(E + b * 256 + ch0 + bj * 128 + 4) * esg; }
#pragma unroll
        for (int ai = 0; ai < 2; ++ai)
#pragma unroll
            for (int m = 0; m < 4; ++m) {
                const int tp = tp0 + ai * 128 + m * 16;
                f32x4 c[2][2]; bf16x8 z1[2], z2[2];
#pragma unroll
                for (int bj = 0; bj < 2; ++bj) {
                    c[bj][0] = p[0]; c[bj][1] = p[512]; p += 1024; asm volatile("" : "+v"(p));
                    z1[bj] = ld8(Z + (size_t)(b * SEQ + tp) * INC + C_FZ + ch0 + bj * 128);
                    z2[bj] = ld8(Z + (size_t)(b * SEQ + (tp > 0 ? SEQ - tp : 0)) * INC + C_FZ + ch0 + bj * 128);
                }
#pragma unroll
                for (int bj = 0; bj < 2; ++bj) {
                    const int ch = ch0 + bj * 128;
                    const f32x4 s0 = acc[ai][bj][m][0], s1 = acc[ai][bj][m][1];
                    const f32x4 p0 = (c[bj][0] + s0 + e0[bj]) * scale, p1 = (c[bj][1] + s1 + e1[bj]) * scale;
                    const f32x4 q0 = (c[bj][0] - s0 + e0[bj]) * scale, q1 = (c[bj][1] - s1 + e1[bj]) * scale;
                    const bf16x8 za = z1[bj], zb = z2[bj];
                    *(bf16x8*)(Y + (size_t)(b * SEQ + tp) * DM + 768 + ch) =
                        pack8(p0[0] * silu_f(bf2f_s(za[0])), p0[1] * silu_f(bf2f_s(za[1])), p0[2] * silu_f(bf2f_s(za[2])), p0[3] * silu_f(bf2f_s(za[3])),
                              p1[0] * silu_f(bf2f_s(za[4])), p1[1] * silu_f(bf2f_s(za[5])), p1[2] * silu_f(bf2f_s(za[6])), p1[3] * silu_f(bf2f_s(za[7])));
                    if (tp > 0)
                        *(bf16x8*)(Y + (size_t)(b * SEQ + SEQ - tp) * DM + 768 + ch) =
                            pack8(q0[0] * silu_f(bf2f_s(zb[0])), q0[1] * silu_f(bf2f_s(zb[1])), q0[2] * silu_f(bf2f_s(zb[2])), q0[3] * silu_f(bf2f_s(zb[3])),
                                  q1[0] * silu_f(bf2f_s(zb[4])), q1[1] * silu_f(bf2f_s(zb[5])), q1[2] * silu_f(bf2f_s(zb[6])), q1[3] * silu_f(bf2f_s(zb[7])));
                }
            }
    }
};

constexpr int P0_MOD = 96, P0_WIN0 = P0_MOD + 896, P0_WIN = P0_MOD + 1792, P0_WOUT = P0_WIN + 512, P0_CS = P0_WOUT + 256, P0_END = P0_CS + 1 + 16;
DI void p0_transpose(const float* W, u16* WT, int K, int N, int kt, int nt, float* tile) {
    const int tid = tidx();
#pragma unroll
    for (int i = 0; i < 2; ++i) {
        const int idx = tid + i * 512, r = idx >> 4, c4 = (idx & 15) * 4;
        const f32x4 v = *(const f32x4*)(W + (size_t)(kt * 64 + r) * N + nt * 64 + c4);
        tile[r * 65 + c4 + 0] = v[0]; tile[r * 65 + c4 + 1] = v[1]; tile[r * 65 + c4 + 2] = v[2]; tile[r * 65 + c4 + 3] = v[3];
    }
    __syncthreads();
    const int n = tid >> 3, ks = tid & 7;
    float v[8];
#pragma unroll
    for (int j = 0; j < 8; ++j) v[j] = tile[(ks * 8 + j) * 65 + n];
    *(bf16x8*)(WT + (size_t)(nt * 64 + n) * K + kt * 64 + ks * 8) = pack8(v[0], v[1], v[2], v[3], v[4], v[5], v[6], v[7]);
    __syncthreads();
}

DI void p0_prologue(const Params& P, unsigned char* lds, int lo_it, int hi_it, int first, int stride) {
    const int tid = tidx();
    float* fl = (float*)lds;
    unsigned char* ws = P.ws;
    constexpr int N_WIN = 2 * 16 * 56, N_WOUT = 2 * 16 * 16, N_CS = 256, N_CSC = 1, N_ROPE = 16, N_MOD = 96;
    constexpr int T0 = N_MOD, T1 = T0 + N_WIN, T2 = T1 + N_WOUT, T3 = T2 + N_CS, T4 = T3 + N_CSC, T5 = T4 + N_ROPE;
    (void)T5;
    for (int it = lo_it + first; it < hi_it; it += stride) {
        if (it < T0) {
            const int l = it / 48, chunk = it % 48;
            float* act = fl;
            float* red = fl + 9 * 1024;
            for (int i = tid; i < 9 * 1024; i += 512) { const int m = i >> 10, k = i & 1023; const float v = m < 8 ? P.c[m * 1024 + k] : P.c_ctx[k]; act[i] = silu_f(v); }
            __syncthreads();
            const int kp = tid >> 6, col = tid & 63, c0 = chunk * 64 + col;
            float acc[9];
#pragma unroll
            for (int m = 0; m < 9; ++m) acc[m] = 0.f;
            const float* wp = P.w_mod + (size_t)l * 1024 * 3072 + c0;
#pragma unroll 16
            for (int k = kp * 128; k < kp * 128 + 128; ++k) {
                const float w = wp[(size_t)k * 3072];
#pragma unroll
                for (int m = 0; m < 9; ++m) acc[m] += act[m * 1024 + k] * w;
            }
#pragma unroll
            for (int m = 0; m < 9; ++m) red[(kp * 9 + m) * 64 + col] = acc[m];
            __syncthreads();
            for (int i = tid; i < 9 * 64; i += 512) {
                const int m = i >> 6, cc = i & 63; float s = 0.f;
#pragma unroll
                for (int q = 0; q < 8; ++q) s += red[(q * 9 + m) * 64 + cc];
                ((float*)(ws + WS_MOD))[(l * 9 + m) * 3072 + chunk * 64 + cc] = s + P.b_mod[l * 3072 + chunk * 64 + cc];
            }
            __syncthreads();
        } else if (it < T1) {
            const int j = it - T0, l = j / 896, r = j % 896, kt = r / 56, nt = r % 56;
            p0_transpose(P.w_in + (size_t)l * DM * INC, (u16*)(ws + WS_WIN) + (size_t)l * INC * DM, DM, INC, kt, nt, fl);
        } else if (it < T2) {
            const int j = it - T1, l = j / 256, r = j % 256, kt = r / 16, nt = r % 16;
            p0_transpose(P.w_out + (size_t)l * DM * DM, (u16*)(ws + WS_WOUT) + (size_t)l * DM * DM, DM, DM, kt, nt, fl);
        } else if (it < T4) {
            float* tab = fl;
            for (int i = tid; i < 4096; i += 512) tab[i] = cospif((float)i * (1.0f / 2048.0f));
            __syncthreads();
            if (it < T3) {
                const int r0 = (it - T2) * 16;
                u16* CS = (u16*)(ws + WS_CS);
                for (int i = tid; i < 16 * 512; i += 512) {
                    const int tp = r0 + (i >> 9), k0 = (i & 511) * 8;
                    float v[8];
#pragma unroll
                    for (int j = 0; j < 8; ++j) {
                        const int k = k0 + j;
                        if (k < 2048) v[j] = tab[(k * tp) & 4095];
                        else v[j] = -tab[(((k - 2048) * tp) - 1024) & 4095];
                    }
                    *(bf16x8*)(CS + (size_t)tp * FK + k0) = pack8(v[0], v[1], v[2], v[3], v[4], v[5], v[6], v[7]);
                }
            } else {
                u16* CSC = (u16*)(ws + WS_CSC);
                for (int i = tid; i < 256 * 64; i += 512) {
                    const int tp = i >> 6, k0 = (i & 63) * 8;
                    float v[8];
#pragma unroll
                    for (int j = 0; j < 8; ++j) {
                        const int k = k0 + j;
                        if (k < 256) v[j] = tab[((k * tp) & 255) * 16];
                        else v[j] = -tab[((((k - 256) * tp) & 255) * 16 - 1024) & 4095];
                    }
                    *(bf16x8*)(CSC + (size_t)tp * FKC + k0) = pack8(v[0], v[1], v[2], v[3], v[4], v[5], v[6], v[7]);
                }
            }
            __syncthreads();
        } else {
            const int p0 = (it - T4) * 256;
            float* rope = (float*)(ws + WS_ROPE);
            for (int i = tid; i < 256 * 32; i += 512) {
                const int pos = p0 + (i >> 5), pi = i & 31, j = pi & 15;
                const float freq = powf(10000.0f, -(float)j / 16.0f);
                const float ang = (float)(pi < 16 ? (pos >> 6) : (pos & 63)) * freq;
                rope[((size_t)pos * 32 + pi) * 2] = cosf(ang);
                rope[((size_t)pos * 32 + pi) * 2 + 1] = sinf(ang);
            }
        }
    }
}

DI void phase_a(const Params& P, int layer) {
    const int tid_ = tidx(); const int lane = tid_ & 63, wave = tid_ >> 6;
    u16* A = (u16*)(P.ws + WS_Y);
    const float* modl = (const float*)(P.ws + WS_MOD) + layer * 9 * 3072;
    const float* g = P.norm_g + layer * DM;
    for (int row = blockIdx.x * 8 + wave; row < NROW; row += gridDim.x * 8) {
        const bool isctx = row >= NLAT;
        const float* md = modl + (isctx ? 8 : row >> 12) * 3072;
        f32x4 v[4]; float ss = 0.f;
        if (layer == 1 && !isctx) {
            const u16* src = (const u16*)P.out + (size_t)row * DM;
#pragma unroll
            for (int i = 0; i < 2; ++i) {
                const bf16x8 t = ld8(src + i * 512 + lane * 8);
#pragma unroll
                for (int j = 0; j < 4; ++j) { v[2 * i][j] = bf2f_s(t[j]); v[2 * i + 1][j] = bf2f_s(t[4 + j]); }
            }
        } else {
            const float* src = layer == 0 ? (isctx ? P.ctx + (size_t)(row - NLAT) * DM : P.x + (size_t)row * DM) : (const float*)(P.ws + WS_HC) + (size_t)(row - NLAT) * DM;
#pragma unroll
            for (int i = 0; i < 2; ++i) { v[2 * i] = *(const f32x4*)(src + i * 512 + lane * 8); v[2 * i + 1] = *(const f32x4*)(src + i * 512 + lane * 8 + 4); }
        }
#pragma unroll
        for (int i = 0; i < 4; ++i) ss += v[i][0] * v[i][0] + v[i][1] * v[i][1] + v[i][2] * v[i][2] + v[i][3] * v[i][3];
#pragma unroll
        for (int o = 32; o >= 1; o >>= 1) ss += __shfl_xor(ss, o);
        const float rstd = rsqrtf(ss * (1.0f / DM) + EPSV);
#pragma unroll
        for (int i = 0; i < 2; ++i) {
            const int c0 = i * 512 + lane * 8;
            float y[8];
#pragma unroll
            for (int h2 = 0; h2 < 2; ++h2) {
                const f32x4 gg = *(const f32x4*)(g + c0 + 4 * h2), sh = *(const f32x4*)(md + c0 + 4 * h2), sc = *(const f32x4*)(md + 1024 + c0 + 4 * h2);
#pragma unroll
                for (int j = 0; j < 4; ++j) y[4 * h2 + j] = v[2 * i + h2][j] * rstd * gg[j] * (1.0f + sc[j]) + sh[j];
            }
            *(bf16x8*)(A + (size_t)row * DM + c0) = pack8(y[0], y[1], y[2], y[3], y[4], y[5], y[6], y[7]);
        }
    }
}

template <int DIR, bool DRY>
DI void hg_sweep2(const Params& P, u16* Z, int it, int row0, const float (&fv)[64], float P1, float P2, const u16* Qs, u16* KdT) {
    unsigned char* dummy = P.ws + WS_HC + (size_t)blockIdx.x * 16384;
    const int tid = tidx(), ch = tid & 255, h = ch >> 6, k = ch & 63;
    u16* km_out = Z + (size_t)row0 * INC + (DIR ? C_HF1 : C_HF0) + ch;
    u16* qm_out = Z + (size_t)row0 * INC + (DIR ? C_HI : C_CB) + ch;
    u16* kd = KdT + ((DIR * 4 + h) * 64 + k) * 72;
    const float kdscale = P2;
    float eq = __builtin_amdgcn_rcpf(P1);
#pragma unroll
    for (int g = 0; g < 8; ++g) {
        float kdv[8];
#pragma unroll
        for (int jj = 0; jj < 8; ++jj) {
            const int i = 8 * g + jj, s = DIR ? 63 - i : i;
            eq *= fv[i];
            const float kk = 1.0f - fv[i];
            const float q = bf2f(Qs[s * 264 + ch]);
            const float qv = q * __builtin_amdgcn_rcpf(1.0f + __expf(-q));
            const float km = kk * __builtin_amdgcn_rcpf(eq);
            *ST(&qm_out[(size_t)s * INC]) = f2bf(qv * eq);
            *ST(&km_out[(size_t)s * INC]) = f2bf(km);
            kdv[DIR ? 7 - jj : jj] = km * kdscale;
        }
        const int s0 = DIR ? 56 - 8 * g : 8 * g;
        *(bf16x8*)(kd + s0) = pack8(kdv[0], kdv[1], kdv[2], kdv[3], kdv[4], kdv[5], kdv[6], kdv[7]);
    }
    const size_t base = ((size_t)it * 4 + h) * 2 + DIR;
    *ST(&((float*)(P.ws + WS_DEC))[base * 64 + k]) = P1 * P2;
    *ST(&((float*)(P.ws + WS_EREF))[base * 64 + k]) = P1;
}

template <int MASK, bool DRY = false>
DI void phase_c_item(const Params& P, int layer, int it, unsigned char* lds) {
    unsigned char* dummy = P.ws + WS_HC + (size_t)blockIdx.x * 16384;
    const int tid = tidx(), lane = tid & 63, wave = tid >> 6, l32 = lane & 31, hh = lane >> 5;
    const int row0 = it * 64;
    const bool isctx = it >= 512;
    const int b = isctx ? (it - 512) >> 2 : it >> 6;
    const int c = isctx ? (it - 512) & 3 : it & 63;
    const int seqlen = isctx ? CTXL : SEQ;
    u16* Z = (u16*)(P.ws + WS_Z);
    u16* Y = (u16*)(P.ws + WS_Y);
    const bool ctx_out = !(isctx && layer == 1);
    if ((MASK & 1) && ctx_out) {
        const float* cw = P.conv_w + layer * 3 * 256;
        const int c8 = (tid & 31) * 8;
        float w0[8], w1[8], w2[8];
#pragma unroll
        for (int j = 0; j < 8; ++j) { w0[j] = cw[c8 + j]; w1[j] = cw[256 + c8 + j]; w2[j] = cw[512 + c8 + j]; }
#pragma unroll 1
        for (int i = 0; i < 2; ++i) {
            bf16x8 vb[2], vc[2], vx[2], vz[2], pc[2], px[2], nc[2], nx[2];
#pragma unroll
            for (int q = 0; q < 2; ++q) {
                const int t = (tid >> 5) + 16 * (2 * i + q), tok = c * 64 + t;
                const u16* zr = Z + (size_t)(row0 + t) * INC + c8;
                const u16* zp = tok > 0 ? zr - INC : zr; const u16* zn = tok < seqlen - 1 ? zr + INC : zr;
                vb[q] = ld8(zr + C_CB); vc[q] = ld8(zr + C_CC); vx[q] = ld8(zr + C_CX); vz[q] = ld8(zr + C_CZ);
                pc[q] = ld8(zp + C_CC); px[q] = ld8(zp + C_CX); nc[q] = ld8(zn + C_CC); nx[q] = ld8(zn + C_CX);
            }
#pragma unroll
            for (int q = 0; q < 2; ++q) {
                const int t = (tid >> 5) + 16 * (2 * i + q), tok = c * 64 + t;
                const float mp = tok > 0 ? 1.0f : 0.0f, mn = tok < seqlen - 1 ? 1.0f : 0.0f;
                float y[8];
#pragma unroll
                for (int j = 0; j < 8; ++j) {
                    const float cv = mp * w0[j] * (bf2f_s(pc[q][j]) * bf2f_s(px[q][j])) + w1[j] * (bf2f_s(vc[q][j]) * bf2f_s(vx[q][j])) + mn * w2[j] * (bf2f_s(nc[q][j]) * bf2f_s(nx[q][j]));
                    y[j] = bf2f_s(vb[q][j]) * cv * silu_f(bf2f_s(vz[q][j]));
                }
                *ST((bf16x8*)(Y + (size_t)(row0 + t) * DM + c8)) = pack8(y[0], y[1], y[2], y[3], y[4], y[5], y[6], y[7]);
            }
        }
    }
    if (MASK & 2) {
        const int t = tid >> 3, dg = tid & 7;
        const size_t r = (size_t)(row0 + t);
        const float* rp = (const float*)(P.ws + WS_ROPE) + ((size_t)(c * 64 + t) * 32 + dg * 4) * 2;
        bf16x8 xv[6];
#pragma unroll
        for (int hs = 0; hs < 6; ++hs) xv[hs] = ld8(Z + r * INC + (hs < 4 ? C_AQ + hs * 64 : C_AK + (hs - 4) * 64) + dg * 8);
        const int rowi = tid >> 2, seg = tid & 3, hkv = rowi >> 6, d = rowi & 63;
        float vv[16];
#pragma unroll
        for (int j = 0; j < 16; ++j) vv[j] = bf2f(Z[(size_t)(row0 + seg * 16 + j) * INC + C_AV + hkv * 64 + d]);
        float rc[4], rs[4];
#pragma unroll
        for (int jj = 0; jj < 4; ++jj) { rc[jj] = isctx ? 1.0f : rp[2 * jj]; rs[jj] = isctx ? 0.0f : rp[2 * jj + 1]; }
#pragma unroll
        for (int hs = 0; hs < 6; ++hs) {
            const float* gain = (hs < 4 ? P.q_g : P.k_g) + layer * 64 + dg * 8;
            u16* p = Z + r * INC + (hs < 4 ? C_AQ + hs * 64 : C_AK + (hs - 4) * 64) + dg * 8;
            float x[8]; float ss = 0.f;
#pragma unroll
            for (int j = 0; j < 8; ++j) { x[j] = bf2f_s(xv[hs][j]); ss += x[j] * x[j]; }
            ss += __shfl_xor(ss, 1); ss += __shfl_xor(ss, 2); ss += __shfl_xor(ss, 4);
            const float rstd = rsqrtf(ss * (1.0f / 64.0f) + EPSV) * (hs < 4 ? QSCALE : 1.0f);
#pragma unroll
            for (int j = 0; j < 8; ++j) x[j] = x[j] * rstd * gain[j];
#pragma unroll
            for (int jj = 0; jj < 4; ++jj) {
                const float x1 = x[2 * jj], x2 = x[2 * jj + 1];
                x[2 * jj] = x1 * rc[jj] - x2 * rs[jj]; x[2 * jj + 1] = x1 * rs[jj] + x2 * rc[jj];
            }
            *ST((bf16x8*)p) = pack8(x[0], x[1], x[2], x[3], x[4], x[5], x[6], x[7]);
        }
        u16* dst = (u16*)(P.ws + WS_VT) + ((size_t)(b * 2 + hkv) * 64 + d) * NKEY + (isctx ? SEQ : 0) + c * 64 + seg * 16;
        *ST((bf16x8*)dst) = pack8(vv[0], vv[1], vv[2], vv[3], vv[8], vv[9], vv[10], vv[11]);
        *ST((bf16x8*)(dst + 8)) = pack8(vv[4], vv[5], vv[6], vv[7], vv[12], vv[13], vv[14], vv[15]);
    }
    if (MASK & 4) {
        float* ctab = (float*)lds;
        if (tid < 128) { const int m = tid & 63; ctab[tid] = tid < 64 ? cospif((float)m * (1.0f / 32.0f)) : sinpif((float)m * (1.0f / 32.0f)); }
        __syncthreads();
        const bool do_mix = isctx ? ctx_out : c < 32;
        if (!isctx && c == 32 && tid < 256) {
            const int g = tid >> 6, cp = tid & 63; float e = 0.f;
            bf16x8 uv[8];
#pragma unroll
            for (int i = 0; i < 8; ++i) uv[i] = ld8(Z + (size_t)row0 * INC + C_FU + g * 64 + 8 * i);
#pragma unroll
            for (int i = 0; i < 8; ++i)
#pragma unroll
                for (int j = 0; j < 8; ++j) e += bf2f_s(uv[i][j]) * ctab[((8 * i + j) * cp) & 63];
            *ST(&((float*)(P.ws + WS_E))[b * 256 + tid]) = e;
        }
        if (do_mix) {
        const int g = wave >> 1, trig = wave & 1;
        const float* tab = ctab + trig * 64;
        f32x16 acc[2][2];
#pragma unroll
        for (int i = 0; i < 2; ++i)
#pragma unroll
            for (int j = 0; j < 2; ++j) acc[i][j] = zero16();
#pragma unroll
        for (int ks = 0; ks < 4; ++ks) {
            bf16x8 bfr[2];
#pragma unroll
            for (int nt = 0; nt < 2; ++nt) {
                const int tl = 32 * nt + l32;
                bf16x8 a = ld8(Z + (size_t)(row0 + tl) * INC + C_FU + g * 64 + 16 * ks + 8 * hh);
                if (!isctx) {
                    const int t = c * 64 + tl;
                    const bf16x8 m = ld8(Z + (size_t)(b * SEQ + (t > 0 ? SEQ - t : 0)) * INC + C_FU + g * 64 + 16 * ks + 8 * hh);
                    const float sgn = t > 0 ? (trig ? -1.0f : 1.0f) : 0.0f;
                    a = pack8(bf2f_s(a[0]) + sgn * bf2f_s(m[0]), bf2f_s(a[1]) + sgn * bf2f_s(m[1]), bf2f_s(a[2]) + sgn * bf2f_s(m[2]), bf2f_s(a[3]) + sgn * bf2f_s(m[3]),
                              bf2f_s(a[4]) + sgn * bf2f_s(m[4]), bf2f_s(a[5]) + sgn * bf2f_s(m[5]), bf2f_s(a[6]) + sgn * bf2f_s(m[6]), bf2f_s(a[7]) + sgn * bf2f_s(m[7]));
                }
                bfr[nt] = a;
            }
#pragma unroll
            for (int mt = 0; mt < 2; ++mt) {
                const int cp = 32 * mt + l32;
                float av[8];
#pragma unroll
                for (int j = 0; j < 8; ++j) av[j] = tab[((16 * ks + 8 * hh + j) * cp) & 63];
                const bf16x8 af = pack8(av[0], av[1], av[2], av[3], av[4], av[5], av[6], av[7]);
#pragma unroll
                for (int nt = 0; nt < 2; ++nt) acc[mt][nt] = MFMA32(af, bfr[nt], acc[mt][nt]);
            }
        }
        u16* stg = (u16*)(lds + 1024 + wave * 9216);
#pragma unroll
        for (int mt = 0; mt < 2; ++mt)
#pragma unroll
            for (int nt = 0; nt < 2; ++nt)
#pragma unroll
                for (int j = 0; j < 16; ++j) stg[(32 * mt + crow(j, hh)) * 72 + 32 * nt + l32] = f2bf(acc[mt][nt][j]);
        __syncthreads();
        const int krow = isctx ? FKC : FK;
        u16* dst = (isctx ? (u16*)(P.ws + WS_UTC) : (u16*)(P.ws + WS_UT)) + (size_t)(b * 256 + g * 64) * krow + (trig ? (isctx ? CTXL : FK / 2) : 0) + c * 64;
        const int seg = (lane & 7) * 8;
        u16* dp = dst + (size_t)(lane >> 3) * krow + seg;
        const u16* sp = stg + (lane >> 3) * 72 + seg;
#pragma unroll 1
        for (int i = 0; i < 8; ++i) { *ST((bf16x8*)dp) = *(const bf16x8*)sp; dp += (size_t)8 * krow; sp += 8 * 72; }
        }
    }
    __syncthreads();
    if (MASK & 8) {
        u16* VtL = (u16*)lds;
        u16* KdT = (u16*)(lds + 36864);
        u16* Qs = (u16*)(lds + 110592);
        {
            const int dir = tid >> 8, ch = tid & 255;
            bf16x8 qp[4];
#pragma unroll
            for (int i = 0; i < 4; ++i) { const int p = tid + 512 * i; qp[i] = ld8(Z + (size_t)(row0 + (p >> 5)) * INC + C_HQ + (p & 31) * 8); }
            float vv[32];
#pragma unroll
            for (int j = 0; j < 32; ++j) vv[j] = bf2f(Z[(size_t)(row0 + 32 * dir + j) * INC + C_HI + ch]);
            float lfv[64];
            {
                const u16* fcol = Z + (size_t)row0 * INC + (dir ? C_HF1 : C_HF0) + ch;
#pragma unroll
                for (int i = 0; i < 64; ++i) lfv[i] = bf2f(fcol[(size_t)(dir ? 63 - i : i) * INC]);
            }
#pragma unroll
            for (int i = 0; i < 4; ++i) { const int p = tid + 512 * i; *(bf16x8*)(Qs + (p >> 5) * 264 + (p & 31) * 8) = qp[i]; }
            {
                u16* gl = (u16*)(P.ws + WS_VTH) + ((size_t)it * 256 + ch) * 64 + 32 * dir;
                u16* ll = VtL + ch * 72 + 32 * dir;
#pragma unroll
                for (int q = 0; q < 4; ++q) {
                    const bf16x8 w = pack8(vv[8 * q], vv[8 * q + 1], vv[8 * q + 2], vv[8 * q + 3], vv[8 * q + 4], vv[8 * q + 5], vv[8 * q + 6], vv[8 * q + 7]);
                    *ST((bf16x8*)(gl + 8 * q)) = w; *(bf16x8*)(ll + 8 * q) = w;
                }
            }
            float lb = 0.f;
            if (layer > 0) { const float l0 = P.hgrn_lb[(dir * 2 + 0) * 256 + ch], l1 = P.hgrn_lb[(dir * 2 + 1) * 256 + ch]; lb = 1.0f / (1.0f + __expf(l0 - l1)); }
            const float oml = 1.0f - lb;
            float P1 = 1.0f, P2 = 1.0f;
#pragma unroll
            for (int i = 0; i < 64; ++i) {
                lfv[i] = lb + oml * __builtin_amdgcn_rcpf(1.0f + __expf(-lfv[i]));
                if (i < 32) P1 *= lfv[i]; else P2 *= lfv[i];
            }
            __syncthreads();
            if (dir == 0) hg_sweep2<0, DRY>(P, Z, it, row0, lfv, P1, P2, Qs, KdT); else hg_sweep2<1, DRY>(P, Z, it, row0, lfv, P1, P2, Qs, KdT);
        }
        __syncthreads();
        {
            const int h = wave & 3, dir = wave >> 2;
            f32x16 acc[2][2];
#pragma unroll
            for (int i = 0; i < 2; ++i)
#pragma unroll
                for (int j = 0; j < 2; ++j) acc[i][j] = zero16();
#pragma unroll
            for (int ks = 0; ks < 4; ++ks) {
                bf16x8 af[2], bfr[2];
#pragma unroll
                for (int mt = 0; mt < 2; ++mt) af[mt] = *(const bf16x8*)(VtL + (h * 64 + 32 * mt + l32) * 72 + 16 * ks + 8 * hh);
#pragma unroll
                for (int nt = 0; nt < 2; ++nt) bfr[nt] = *(const bf16x8*)(KdT + ((dir * 4 + h) * 64 + 32 * nt + l32) * 72 + 16 * ks + 8 * hh);
#pragma unroll
                for (int mt = 0; mt < 2; ++mt)
#pragma unroll
                    for (int nt = 0; nt < 2; ++nt) acc[mt][nt] = MFMA32(af[mt], bfr[nt], acc[mt][nt]);
            }
            u16* dst = (u16*)(P.ws + WS_G) + (((size_t)it * 4 + h) * 2 + dir) * 4096;
#pragma unroll
            for (int mt = 0; mt < 2; ++mt)
#pragma unroll
                for (int nt = 0; nt < 2; ++nt)
#pragma unroll
                    for (int j = 0; j < 16; ++j) *ST(&dst[(32 * mt + crow(j, hh)) * 64 + 32 * nt + l32]) = f2bf(acc[mt][nt][j]);
        }
        __syncthreads();
    }
}

template <bool DRY>
DI void hg_scan_item(const Params& P, int it) {
    unsigned char* dummy = P.ws + WS_HC + (size_t)blockIdx.x * 16384;
    const int tid = tidx();
    const int b = it >> 3, h = (it >> 1) & 3, dir = it & 1;
    const int k0 = (tid & 7) * 8;
    float S[8];
#pragma unroll
    for (int j = 0; j < 8; ++j) S[j] = 0.f;
    u16* G = (u16*)(P.ws + WS_G);
    const float* dec = (const float*)(P.ws + WS_DEC);
    const float* eref = (const float*)(P.ws + WS_EREF);
#pragma unroll 1
    for (int j0 = 0; j0 < 68; j0 += 4) {
        u16* gp[4]; bf16x8 g[4]; f32x4 dc[4][2], er[4][2];
#pragma unroll
        for (int q = 0; q < 4; ++q) {
            const int j = j0 + q;
            const int ci = dir == 0 ? (j < 4 ? 512 + 4 * b + j : 64 * b + j - 4) : (j < 4 ? 512 + 4 * b + 3 - j : 64 * b + 67 - j);
            const size_t base = ((size_t)ci * 4 + h) * 2 + dir;
            gp[q] = G + base * 4096 + tid * 8;
            g[q] = ld8(gp[q]);
            dc[q][0] = *(const f32x4*)(dec + base * 64 + k0); dc[q][1] = *(const f32x4*)(dec + base * 64 + k0 + 4);
            er[q][0] = *(const f32x4*)(eref + base * 64 + k0); er[q][1] = *(const f32x4*)(eref + base * 64 + k0 + 4);
        }
#pragma unroll
        for (int q = 0; q < 4; ++q) {
            float o[8];
#pragma unroll
            for (int j = 0; j < 8; ++j) { o[j] = S[j] * er[q][j >> 2][j & 3]; S[j] = dc[q][j >> 2][j & 3] * S[j] + bf2f_s(g[q][j]); }
            u16* gq = gp[q];
            *ST((bf16x8*)gq) = pack8(o[0], o[1], o[2], o[3], o[4], o[5], o[6], o[7]);
        }
    }
}

DI void attn_item(const Params& P, int layer, int item, unsigned char* lds) {
    const int tid = tidx(), lane = tid & 63, wave = tid >> 6, l32 = lane & 31, hh = lane >> 5;
    int b, hkv, qrow0, t_lo;
    if (item < 512) { b = item >> 6; hkv = (item >> 5) & 1; qrow0 = b * SEQ + (item & 31) * 128; t_lo = 0; }
    else { const int j = item - 512; b = j >> 2; hkv = (j >> 1) & 1; qrow0 = NLAT + b * CTXL + (j & 1) * 128; t_lo = 64; }
    const int t_hi = 68;
    const u16* Z = (const u16*)(P.ws + WS_Z);
    const u16* Vt = (const u16*)(P.ws + WS_VT) + (size_t)(b * 2 + hkv) * 64 * NKEY;
    const int hq = hkv * 2 + (wave >> 2);
    const size_t qrow = (size_t)(qrow0 + (wave & 3) * 32 + l32);
    float mshift;
    {
        float gq = fabsf(P.q_g[layer * 64 + lane]), gk = fabsf(P.k_g[layer * 64 + lane]);
#pragma unroll
        for (int o = 32; o >= 1; o >>= 1) { gq = fmaxf(gq, __shfl_xor(gq, o)); gk = fmaxf(gk, __shfl_xor(gk, o)); }
        const float bound = QSCALE * 64.0f * gq * gk;
        mshift = bound > 60.0f ? bound : 0.0f;
    }
    const f32x16 cinit = zero16();
    bf16x8 Qf[4];
#pragma unroll
    for (int ks = 0; ks < 4; ++ks) Qf[ks] = ld8(Z + qrow * INC + C_AQ + hq * 64 + 16 * ks + 8 * hh);
    const int lr = tid >> 3, lseg = (tid & 7) * 8;
    auto krow_of = [&](int t) { return t < 64 ? b * SEQ + 64 * t : NLAT + b * CTXL + 64 * (t - 64); };
    const int NP = (t_hi - t_lo) >> 1;
    bf16x8 kreg[2], vreg[2];
#define ATT_GLOAD(pp) do { _Pragma("unroll") for (int u = 0; u < 2; ++u) { const int tt = t_lo + 2 * (pp) + u; \
        kreg[u] = ld8(Z + (size_t)(krow_of(tt) + lr) * INC + C_AK + hkv * 64 + lseg); vreg[u] = ld8(Vt + (size_t)lr * NKEY + 64 * tt + lseg); } } while (0)
#define ATT_LWRITE(pp) do { unsigned char* bb = lds + ((pp) % 3) * 36864; _Pragma("unroll") for (int u = 0; u < 2; ++u) { \
        *(bf16x8*)((u16*)(bb + u * 18432) + lr * 72 + lseg) = kreg[u]; *(bf16x8*)((u16*)(bb + u * 18432 + 9216) + lr * 72 + lseg) = vreg[u]; } } while (0)
#define ATT_LDK(Ks) do { _Pragma("unroll") for (int mt = 0; mt < 2; ++mt) _Pragma("unroll") for (int ks = 0; ks < 4; ++ks) fr[mt * 4 + ks] = *(const bf16x8*)((Ks) + (32 * mt + l32) * 72 + 16 * ks + 8 * hh); } while (0)
#define ATT_LDV(Vs) do { _Pragma("unroll") for (int s4 = 0; s4 < 4; ++s4) _Pragma("unroll") for (int mo = 0; mo < 2; ++mo) fr[s4 * 2 + mo] = *(const bf16x8*)((Vs) + (32 * mo + l32) * 72 + 16 * s4 + 8 * hh); } while (0)
#define ATT_QK(dst) do { _Pragma("unroll") for (int mt = 0; mt < 2; ++mt) { dst[mt] = MFMA32(fr[mt * 4], Qf[0], cinit); \
        _Pragma("unroll") for (int ks = 1; ks < 4; ++ks) dst[mt] = MFMA32(fr[mt * 4 + ks], Qf[ks], dst[mt]); } } while (0)
#define ATT_SOFT_PV(sv) do { float rs0 = 0.f, rs1 = 0.f; \
        if (mshift != 0.f) { _Pragma("unroll") for (int mt = 0; mt < 2; ++mt) _Pragma("unroll") for (int j = 0; j < 16; ++j) sv[mt][j] -= mshift; } \
        _Pragma("unroll") for (int mt = 0; mt < 2; ++mt) _Pragma("unroll") for (int j = 0; j < 16; j += 2) { \
            const float p0 = __builtin_amdgcn_exp2f(sv[mt][j]), p1 = __builtin_amdgcn_exp2f(sv[mt][j + 1]); sv[mt][j] = p0; sv[mt][j + 1] = p1; rs0 += p0; rs1 += p1; } \
        l_run += rs0 + rs1; \
        _Pragma("unroll") for (int s4 = 0; s4 < 4; ++s4) { const int mt = s4 >> 1, s = s4 & 1; \
            const bf16x8 pf = pack8(sv[mt][8 * s], sv[mt][8 * s + 1], sv[mt][8 * s + 2], sv[mt][8 * s + 3], sv[mt][8 * s + 4], sv[mt][8 * s + 5], sv[mt][8 * s + 6], sv[mt][8 * s + 7]); \
            _Pragma("unroll") for (int mo = 0; mo < 2; ++mo) oT[mo] = MFMA32(fr[s4 * 2 + mo], pf, oT[mo]); } } while (0)
#define ATT_SB __builtin_amdgcn_sched_barrier(0)
    ATT_GLOAD(0);
    __syncthreads();
    ATT_LWRITE(0);
    if (NP > 1) ATT_GLOAD(1);
    __syncthreads();
    f32x16 oT[2]; oT[0] = zero16(); oT[1] = zero16();
    float l_run = 0.f;
    f32x16 sA[2], sB[2];
    bf16x8 fr[8];
    ATT_LDK((const u16*)lds);
    ATT_QK(sA);
#pragma unroll 1
    for (int p = 0; p < NP; ++p) {
        const unsigned char* cb = lds + (p % 3) * 36864;
        const unsigned char* nb = lds + ((p + 1) % 3) * 36864;
        ATT_LDK((const u16*)(cb + 18432));
        if (p + 1 < NP) ATT_LWRITE(p + 1);
        if (p + 2 < NP) ATT_GLOAD(p + 2);
        ATT_SB;
        ATT_QK(sB);
        ATT_SB;
        ATT_LDV((const u16*)(cb + 9216));
        ATT_SB;
        ATT_SOFT_PV(sA);
        ATT_SB;
        __syncthreads();
        if (p + 1 < NP) {
            ATT_LDK((const u16*)nb);
            ATT_SB;
            ATT_QK(sA);
            ATT_SB;
        }
        ATT_LDV((const u16*)(cb + 18432 + 9216));
        ATT_SB;
        ATT_SOFT_PV(sB);
        ATT_SB;
    }
#undef ATT_GLOAD
#undef ATT_LWRITE
#undef ATT_LDK
#undef ATT_LDV
#undef ATT_QK
#undef ATT_SOFT_PV
#undef ATT_SB
    s16x4 azv[2][4];
#pragma unroll
    for (int mo = 0; mo < 2; ++mo)
#pragma unroll
        for (int g4 = 0; g4 < 4; ++g4) azv[mo][g4] = ld4(Z + qrow * INC + C_AZ + hq * 64 + 32 * mo + 8 * g4 + 4 * hh);
    const float l_tot = l_run + __shfl_xor(l_run, 32);
    const float inv = 1.0f / l_tot;
    u16* Y = (u16*)(P.ws + WS_Y);
#pragma unroll
    for (int mo = 0; mo < 2; ++mo)
#pragma unroll
        for (int g4 = 0; g4 < 4; ++g4) {
            const int d0 = 32 * mo + 8 * g4 + 4 * hh;
            const s16x4 az = azv[mo][g4];
            u32x2 w;
            w.x = pack2(oT[mo][4 * g4] * inv * silu_f(bf2f_s(az[0])), oT[mo][4 * g4 + 1] * inv * silu_f(bf2f_s(az[1])));
            w.y = pack2(oT[mo][4 * g4 + 2] * inv * silu_f(bf2f_s(az[2])), oT[mo][4 * g4 + 3] * inv * silu_f(bf2f_s(az[3])));
            *(u32x2*)(Y + qrow * DM + 256 + hq * 64 + d0) = w;
        }
}

DI void hg_out_item(const Params& P, int layer, int it, unsigned char* lds) {
    const int tid = tidx(), lane = tid & 63, wave = tid >> 6, l32 = lane & 31, hh = lane >> 5;
    const int row0 = it * 64, h = wave >> 1, nt = wave & 1, t = 32 * nt + l32;
    const u16* Z = (const u16*)(P.ws + WS_Z);
    const u16* G = (const u16*)(P.ws + WS_G);
    const u16* VtH = (const u16*)(P.ws + WS_VTH) + (size_t)it * 4 * 4096;
    u16* QmL = (u16*)lds; u16* KmL = (u16*)(lds + 36864); u16* SsL = (u16*)(lds + 73728); u16* VL = (u16*)(lds + 110592);
    f32x16 oT[2]; oT[0] = zero16(); oT[1] = zero16();
    bf16x8 rq[4], rk[4], rs[4], rv[4];
#define HG_GLOAD(dir) do { const int qc = (dir) ? C_HI : C_CB, kc = (dir) ? C_HF1 : C_HF0; \
        _Pragma("unroll") for (int i = 0; i < 4; ++i) { const int p = tid + 512 * i; \
            rq[i] = ld8(Z + (size_t)(row0 + (p >> 5)) * INC + qc + (p & 31) * 8); rk[i] = ld8(Z + (size_t)(row0 + (p >> 5)) * INC + kc + (p & 31) * 8); \
            rs[i] = ld8(G + (((size_t)it * 4 + (p >> 9)) * 2 + (dir)) * 4096 + (p & 511) * 8); } } while (0)
#define HG_LWRITE() do { _Pragma("unroll") for (int i = 0; i < 4; ++i) { const int p = tid + 512 * i; \
            const int o1 = ((p & 31) >> 3) * 4608 + (p >> 5) * 72 + (p & 7) * 8; *(bf16x8*)(QmL + o1) = rq[i]; *(bf16x8*)(KmL + o1) = rk[i]; \
            *(bf16x8*)(SsL + (p >> 9) * 4608 + ((p >> 3) & 63) * 72 + (p & 7) * 8) = rs[i]; } } while (0)
    HG_GLOAD(0);
#pragma unroll
    for (int i = 0; i < 4; ++i) { const int p = tid + 512 * i; rv[i] = ld8(VtH + (size_t)p * 8); }
    __syncthreads();
    HG_LWRITE();
#pragma unroll
    for (int i = 0; i < 4; ++i) { const int p = tid + 512 * i; *(bf16x8*)(VL + (p >> 3) * 72 + (p & 7) * 8) = rv[i]; }
    HG_GLOAD(1);
    __syncthreads();
#pragma unroll
    for (int dir = 0; dir < 2; ++dir) {
        const u16* Qh = QmL + h * 4608; const u16* Kh = KmL + h * 4608; const u16* Sh = SsL + h * 4608; const u16* Vh = VL + h * 4608;
        const int mt_off = nt ^ 1;
        const bool need_off = dir == 0 ? (mt_off < nt) : (mt_off > nt);
        bf16x8 Qf[4];
#pragma unroll
        for (int ks = 0; ks < 4; ++ks) Qf[ks] = *(const bf16x8*)(Qh + t * 72 + 16 * ks + 8 * hh);
#pragma unroll
        for (int ks = 0; ks < 4; ++ks)
#pragma unroll
            for (int mo = 0; mo < 2; ++mo) oT[mo] = MFMA32(*(const bf16x8*)(Sh + (32 * mo + l32) * 72 + 16 * ks + 8 * hh), Qf[ks], oT[mo]);
        {
            f32x16 sT = zero16();
#pragma unroll
            for (int ks = 0; ks < 4; ++ks) sT = MFMA32(*(const bf16x8*)(Kh + (32 * nt + l32) * 72 + 16 * ks + 8 * hh), Qf[ks], sT);
#pragma unroll
            for (int j = 0; j < 16; ++j) { const int sl = crow(j, hh); const bool keep = dir == 0 ? (sl <= l32) : (sl >= l32); sT[j] = keep ? sT[j] : 0.f; }
#pragma unroll
            for (int s = 0; s < 2; ++s) {
                const bf16x8 pf = pack8(sT[8 * s], sT[8 * s + 1], sT[8 * s + 2], sT[8 * s + 3], sT[8 * s + 4], sT[8 * s + 5], sT[8 * s + 6], sT[8 * s + 7]);
#pragma unroll
                for (int mo = 0; mo < 2; ++mo) {
                    const u16* vp = Vh + (32 * mo + l32) * 72 + 32 * nt + 16 * s + 4 * hh;
                    oT[mo] = MFMA32(__builtin_shufflevector(*(const s16x4*)vp, *(const s16x4*)(vp + 8), 0, 1, 2, 3, 4, 5, 6, 7), pf, oT[mo]);
                }
            }
        }
        if (need_off) {
            f32x16 sT = zero16();
#pragma unroll
            for (int ks = 0; ks < 4; ++ks) sT = MFMA32(*(const bf16x8*)(Kh + (32 * mt_off + l32) * 72 + 16 * ks + 8 * hh), Qf[ks], sT);
#pragma unroll
            for (int s = 0; s < 2; ++s) {
                const bf16x8 pf = pack8(sT[8 * s], sT[8 * s + 1], sT[8 * s + 2], sT[8 * s + 3], sT[8 * s + 4], sT[8 * s + 5], sT[8 * s + 6], sT[8 * s + 7]);
#pragma unroll
                for (int mo = 0; mo < 2; ++mo) {
                    const u16* vp = Vh + (32 * mo + l32) * 72 + 32 * mt_off + 16 * s + 4 * hh;
                    oT[mo] = MFMA32(__builtin_shufflevector(*(const s16x4*)vp, *(const s16x4*)(vp + 8), 0, 1, 2, 3, 4, 5, 6, 7), pf, oT[mo]);
                }
            }
        }
        if (dir == 0) { __syncthreads(); HG_LWRITE(); __syncthreads(); }
    }
#undef HG_GLOAD
#undef HG_LWRITE
    float ss = 0.f;
#pragma unroll
    for (int mo = 0; mo < 2; ++mo)
#pragma unroll
        for (int j = 0; j < 16; ++j) ss += oT[mo][j] * oT[mo][j];
    ss += __shfl_xor(ss, 32);
    const float rstd = rsqrtf(ss * (1.0f / 64.0f) + EPSV);
    u16* Y = (u16*)(P.ws + WS_Y);
    const size_t row = (size_t)(row0 + t);
    f32x4 gnv[2][4]; s16x4 hzv[2][4];
#pragma unroll
    for (int mo = 0; mo < 2; ++mo)
#pragma unroll
        for (int g4 = 0; g4 < 4; ++g4) {
            const int v0 = 32 * mo + 8 * g4 + 4 * hh;
            gnv[mo][g4] = *(const f32x4*)(P.hg_g + layer * 256 + h * 64 + v0);
            hzv[mo][g4] = ld4(Z + row * INC + C_HZ + h * 64 + v0);
        }
#pragma unroll
    for (int mo = 0; mo < 2; ++mo)
#pragma unroll
        for (int g4 = 0; g4 < 4; ++g4) {
            const int v0 = 32 * mo + 8 * g4 + 4 * hh;
            const f32x4 gn = gnv[mo][g4]; const s16x4 hz = hzv[mo][g4];
            u32x2 w;
            w.x = pack2(oT[mo][4 * g4] * rstd * gn[0] * silu_f(bf2f_s(hz[0])), oT[mo][4 * g4 + 1] * rstd * gn[1] * silu_f(bf2f_s(hz[1])));
            w.y = pack2(oT[mo][4 * g4 + 2] * rstd * gn[2] * silu_f(bf2f_s(hz[2])), oT[mo][4 * g4 + 3] * rstd * gn[3] * silu_f(bf2f_s(hz[3])));
            *(u32x2*)(Y + row * DM + 512 + h * 64 + v0) = w;
        }
}

DI void four_row2048_item(const Params& P, int b, int j) {
    const int tid = tidx(), lane = tid & 63, wave = tid >> 6;
    const float* E = (const float*)(P.ws + WS_E) + b * 256;
    const u16* Z = (const u16*)(P.ws + WS_Z);
    u16* Y = (u16*)(P.ws + WS_Y);
    const size_t r = (size_t)(b * SEQ + 2048);
    bf16x8 v[4][4];
#pragma unroll
    for (int nn = 0; nn < 4; ++nn) {
        const u16* up = (const u16*)(P.ws + WS_UT) + (size_t)(b * 256 + j * 32 + wave * 4 + nn) * FK;
#pragma unroll
        for (int i = 0; i < 4; ++i) v[nn][i] = ld8(up + (i * 64 + lane) * 8);
    }
#pragma unroll
    for (int nn = 0; nn < 4; ++nn) {
        const int n = j * 32 + wave * 4 + nn;
        float acc = 0.f;
#pragma unroll
        for (int i = 0; i < 4; ++i) {
            const bf16x8 w = v[nn][i];
            acc += (bf2f_s(w[0]) - bf2f_s(w[1])) + (bf2f_s(w[2]) - bf2f_s(w[3])) + (bf2f_s(w[4]) - bf2f_s(w[5])) + (bf2f_s(w[6]) - bf2f_s(w[7]));
        }
#pragma unroll
        for (int o = 32; o >= 1; o >>= 1) acc += __shfl_xor(acc, o);
        if (lane == 0) Y[r * DM + 768 + n] = f2bf((acc + E[n]) * (1.0f / 512.0f) * silu_f(bf2f(Z[r * INC + C_FZ + n])));
    }
}

DI void ctx_outproj(const Params& P, int G, int bx) {
    const int tid = tidx(), lane = tid & 63, wave = tid >> 6, l32 = lane & 31, hh = lane >> 5;
    const u16* Y = (const u16*)(P.ws + WS_Y);
    const u16* Wt = (const u16*)(P.ws + WS_WOUT);
    const float* gate = (const float*)(P.ws + WS_MOD) + 8 * 3072 + 2048;
    float* hc = (float*)(P.ws + WS_HC);
#pragma unroll 1
    for (int tile = bx; tile < 256; tile += G) {
        const int rb = tile >> 3, cb = tile & 7, r0 = rb * 64 + (wave >> 2) * 32, c0 = cb * 128 + (wave & 3) * 32;
        const u16* ap = Y + (size_t)(NLAT + r0 + l32) * DM + 8 * hh;
        const u16* bp = Wt + (size_t)(c0 + l32) * DM + 8 * hh;
        f32x16 acc = zero16();
#pragma unroll 8
        for (int ks = 0; ks < 64; ++ks) acc = MFMA32(ld8(ap + 16 * ks), ld8(bp + 16 * ks), acc);
        const float gv = gate[c0 + l32];
        float res[16];
#pragma unroll
        for (int j = 0; j < 16; ++j) res[j] = P.ctx[(size_t)(r0 + crow(j, hh)) * DM + c0 + l32];
#pragma unroll
        for (int j = 0; j < 16; ++j) hc[(size_t)(r0 + crow(j, hh)) * DM + c0 + l32] = res[j] + gv * acc[j];
    }
}

DI void phase_g(const Params& P) {
    const int tid_ = tidx(); const int lane = tid_ & 63, wave = tid_ >> 6;
    const u16* H2 = (const u16*)(P.ws + WS_Z);
    for (int row = blockIdx.x * 8 + wave; row < NLAT; row += gridDim.x * 8) {
        const u16* src = H2 + (size_t)row * DM;
        float* p = P.out + (size_t)row * DM;
        f32x4 v[4]; float ss = 0.f;
#pragma unroll
        for (int i = 0; i < 2; ++i) {
            const bf16x8 t = ld8(src + i * 512 + lane * 8);
#pragma unroll
            for (int j = 0; j < 4; ++j) { v[2 * i][j] = bf2f_s(t[j]); v[2 * i + 1][j] = bf2f_s(t[4 + j]); }
        }
#pragma unroll
        for (int i = 0; i < 4; ++i) ss += v[i][0] * v[i][0] + v[i][1] * v[i][1] + v[i][2] * v[i][2] + v[i][3] * v[i][3];
#pragma unroll
        for (int o = 32; o >= 1; o >>= 1) ss += __shfl_xor(ss, o);
        const float rstd = rsqrtf(ss * (1.0f / DM) + EPSV);
#pragma unroll
        for (int i = 0; i < 2; ++i)
#pragma unroll
            for (int h2 = 0; h2 < 2; ++h2) {
                const int c0 = i * 512 + lane * 8 + 4 * h2;
                const f32x4 gg = *(const f32x4*)(P.final_g + c0);
                *(f32x4*)(p + c0) = v[2 * i + h2] * rstd * gg;
            }
    }
}

__global__ void __launch_bounds__(512, 2) fwd_megakernel(Params P) {
    extern __shared__ __attribute__((aligned(16))) unsigned char lds[];
    cg::grid_group grid = cg::this_grid();
    PG8_LAS unsigned char* lds3 = (PG8_LAS unsigned char*)lds;
    const int lo = P.ph_lo, hi = P.ph_hi;
    if (lo < 0) grid.sync();
    const int G = gridDim.x, bx = blockIdx.x;
#define IN(k) (lo <= (k) && (k) < hi)
    volatile LAS unsigned* xst = (volatile LAS unsigned*)(lds3 + LDS_CTL + 64);
    if (threadIdx.x == 0) { xst[0] = 0u; xst[1] = 0u; }
    __syncthreads();
    XcdBarrier xbar; xbar.bar = (unsigned*)(P.ws + WS_BAR); xbar.x = 0; xbar.st = xst;
    if (!MK_PER_PHASE) xbar = xcd_barrier_post((unsigned*)(P.ws + WS_BAR), xst);
#define SEAM(k) do { if (!MK_PER_PHASE && IN(k) && IN((k) + 1)) { xcd_barrier(xbar); } } while (0)
    if (IN(0)) {
        const Params Q = launder(P);
        p0_prologue(Q, lds, 0, P0_WIN0, bx, G);
        p0_prologue(Q, lds, P0_CS, P0_END, bx, G);
    }
    SEAM(0);
#pragma unroll 1
    for (int layer_ = 0; layer_ < 2; ++layer_) {
        int layer = layer_; asm volatile("" : "+s"(layer));
        const int pb = 1 + 6 * layer_;
        if (IN(pb + 0)) { const Params Q = launder(P); phase_a(Q, layer); }
        SEAM(pb + 0);
        if (IN(pb + 1)) {
            const Params Q = launder(P); u16* Z = (u16*)(Q.ws + WS_Z);
            pg8::Gemm g{(const u16*)(Q.ws + WS_Y), (const u16*)(Q.ws + WS_WIN) + (size_t)layer * INC * DM, NROW, INC, DM};
            pg8::StaticOrder S; S.init(NROW, INC, G, bx);
            pg8::EpiBf16<0> E{Z, INC, nullptr, 0, 0};
            pg8::gemm_phase<pg8::EpiBf16<0>, pg8::StaticOrder>(lds3, g, S, E);
            if (layer == 0) {
                const int nfull = (NROW / 256) * (INC / 256) % G;
                __syncthreads();
                if (bx >= nfull) p0_prologue(Q, lds, P0_WIN0, P0_WOUT, bx - nfull, G - nfull);
            }
        }
        SEAM(pb + 1);
        if (IN(pb + 2)) {
            const Params Q = launder(P);
#pragma unroll 1
            for (int it = bx; it < NCHUNK; it += G) phase_c_item<15>(Q, layer, it, lds);
            if (layer == 0) {
                const int nfull = NCHUNK % G;
                __syncthreads();
                if (bx >= nfull) p0_prologue(Q, lds, P0_WOUT, P0_CS, bx - nfull, G - nfull);
            }
        }
        SEAM(pb + 2);
        if (IN(pb + 3)) {
            const Params Q = launder(P); u16* Z = (u16*)(Q.ws + WS_Z); u16* Y = (u16*)(Q.ws + WS_Y);
#pragma unroll 1
            for (int it = (bx + G - G / 2) % G; it < 64; it += G) hg_scan_item<false>(Q, it);
            unsigned* scan_done = (unsigned*)(Q.ws + WS_CTR) + layer * 256 + 200;
            __threadfence(); __syncthreads();
            if (tidx() == 0) __hip_atomic_fetch_add(scan_done, 1u, __ATOMIC_RELAXED, __HIP_MEMORY_SCOPE_AGENT);
            { const int rep = 0;
            {
                pg8::Gemm g{(const u16*)(Q.ws + WS_CS), (const u16*)(Q.ws + WS_UT), SEQ / 2, 2048, FK};
                pg8::StaticOrder S; S.init(SEQ / 2, 2048, G, bx);
                EpiFourM E{Z, Y, 1.0f / 512.0f, (const float*)(Q.ws + WS_E), (f32x4*)(Q.ws + WS_STASH) + (size_t)(bx & 63) * 16384};
                pg8::gemm_phase<EpiFourM, pg8::StaticOrder>(lds3, g, S, E);
            }
            if (layer == 0) {
                pg8::Gemm g{(const u16*)(Q.ws + WS_CSC), (const u16*)(Q.ws + WS_UTC), CTXL, 2048, FKC};
                pg8::StaticOrder S; S.init(CTXL, 2048, G, (bx + G - 128) % G);
                EpiFour E{Z, Y, 1, 1.0f / 128.0f, nullptr};
                pg8::gemm_phase<EpiFour, pg8::StaticOrder>(lds3, g, S, E);
            }
            __syncthreads();
            {
                const int xq = bx & 7;
                unsigned* ctr = (unsigned*)(Q.ws + WS_CTR) + layer * 256 + xq * 16 + rep * 128;
                volatile int* slot = (volatile int*)(lds + LDS_CTL);
                const int n_actx = layer == 0 ? 4 : 0, n_hctx = layer == 0 ? 4 : 0;
                const int e0 = 8, e1 = e0 + 64, e2 = e1 + n_actx, e3 = e2 + 64, e4 = e3 + n_hctx;
                bool scan_ok = false;
                for (;;) {
                    __syncthreads();
                    if (tidx() == 0) *slot = (int)atomicAdd(ctr, 1u);
                    __syncthreads();
                    const int e = *slot;
                    if (e >= e4) break;
                    if (e < e0) four_row2048_item(Q, xq, e);
                    else if (e < e2) attn_item(Q, layer, e < e1 ? 64 * xq + (e - e0) : 512 + 4 * xq + (e - e1), lds);
                    else {
                        if (!scan_ok) {
                            if (tidx() == 0) { unsigned sp = 0; while (__hip_atomic_load(scan_done, __ATOMIC_RELAXED, __HIP_MEMORY_SCOPE_AGENT) < (unsigned)G && ++sp < (1u << 22)) __builtin_amdgcn_s_sleep(2); }
                            __syncthreads();
                            __builtin_amdgcn_fence(__ATOMIC_ACQUIRE, "agent");
                            asm volatile("s_waitcnt vmcnt(0)" ::: "memory");
                            scan_ok = true;
                        }
                        hg_out_item(Q, layer, e < e3 ? 64 * xq + (e - e2) : 512 + 4 * xq + (e - e3), lds);
                    }
                }
            }
            }
        }
        SEAM(pb + 3);
        if (IN(pb + 5)) {
            const Params Q = launder(P);
            const int M = NLAT;
            pg8::Gemm g{(const u16*)(Q.ws + WS_Y), (const u16*)(Q.ws + WS_WOUT) + (size_t)layer * DM * DM, M, DM, DM};
            pg8::StaticOrder S; S.init(M, DM, G, bx);
            EpiRes E{Q.x, (const u16*)Q.out, layer == 0 ? (u16*)Q.out : (u16*)(Q.ws + WS_Z), (const float*)(Q.ws + WS_MOD) + layer * 9 * 3072, layer == 0 ? 0 : 1};
            pg8::gemm_phase<EpiRes, pg8::StaticOrder>(lds3, g, S, E);
            if (layer == 0) ctx_outproj(Q, G, bx);
        }
        SEAM(pb + 5);
    }
    if (IN(13)) { const Params Q = launder(P); phase_g(Q); }
#undef IN
#undef SEAM
}

extern "C" void kernel_launch(void* const* d_in, const int* in_sizes, int n_in, void* d_out, int out_size, void* d_ws, size_t ws_size, hipStream_t stream) {
    static int grid = 0;
    if (grid == 0) {
        if (n_in != 15 || ws_size < WS_END) { fprintf(stderr, "kernel_launch: need 15 inputs and >= %zu bytes of workspace (got %d, %zu)\n", (size_t)WS_END, n_in, ws_size); grid = -1; return; }
        int dev = 0, cus = 0, per_cu = 0;
        (void)hipGetDevice(&dev);
        (void)hipDeviceGetAttribute(&cus, hipDeviceAttributeMultiprocessorCount, dev);
        if (hipFuncSetAttribute((const void*)fwd_megakernel, hipFuncAttributeMaxDynamicSharedMemorySize, LDS_BYTES) != hipSuccess) { fprintf(stderr, "kernel_launch: hipFuncSetAttribute failed\n"); grid = -1; return; }
        if (hipOccupancyMaxActiveBlocksPerMultiprocessor(&per_cu, (const void*)fwd_megakernel, 512, LDS_BYTES) != hipSuccess || per_cu < 1) { fprintf(stderr, "kernel_launch: occupancy query says %d blocks per CU\n", per_cu); per_cu = 1; }
        (void)hipGetLastError();
        grid = cus;
    }
    if (grid < 0) return;
    (void)hipMemsetAsync((char*)d_ws + WS_CTR, 0, WS_CTL_BYTES, stream);
    Params p{};
    p.x = (const float*)d_in[0]; p.c = (const float*)d_in[1]; p.ctx = (const float*)d_in[2]; p.c_ctx = (const float*)d_in[3]; p.norm_g = (const float*)d_in[4];
    p.w_mod = (const float*)d_in[5]; p.b_mod = (const float*)d_in[6]; p.w_in = (const float*)d_in[7]; p.conv_w = (const float*)d_in[8]; p.q_g = (const float*)d_in[9];
    p.k_g = (const float*)d_in[10]; p.hgrn_lb = (const float*)d_in[11]; p.hg_g = (const float*)d_in[12]; p.w_out = (const float*)d_in[13]; p.final_g = (const float*)d_in[14];
    p.out = (float*)d_out; p.ws = (unsigned char*)d_ws;
#if MK_PER_PHASE
    for (int ph = 0; ph < 14; ++ph) {
        p.ph_lo = ph; p.ph_hi = ph + 1;
        hipLaunchKernelGGL(fwd_megakernel, dim3(grid), dim3(512), LDS_BYTES, stream, p);
    }
#else
    p.ph_lo = 0; p.ph_hi = 14;
    void* args[] = {&p};
    hipError_t e = hipLaunchCooperativeKernel((void*)fwd_megakernel, dim3(grid), dim3(512), args, LDS_BYTES, stream);
    if (e != hipSuccess) fprintf(stderr, "cooperative launch failed: %s (grid %d)\n", hipGetErrorString(e), grid);
#endif
}
```

```cpp
#include <hip/hip_runtime.h>
#include <hip/hip_cooperative_groups.h>
#include <cstdio>
namespace cg = cooperative_groups;
#ifndef MK_PER_PHASE
#define MK_PER_PHASE 0
#endif
namespace pg8 {
#define PG8_LAS __attribute__((address_space(3)))
typedef unsigned short bf16_t;
typedef short bf16x8 __attribute__((ext_vector_type(8)));
typedef float f32x4 __attribute__((ext_vector_type(4)));
typedef unsigned u32x4 __attribute__((ext_vector_type(4)));
constexpr int BM = 256, BK = 64, HALF = 128, HTB = HALF * BK * 2  , STAGE_BYTES = 8 * HTB, NXCD = 8, WGM = 8;

__host__ __device__ __forceinline__ int lds_byte(int r, int c) { const int st = (r >> 4) * 2 + (c >> 5), rr = r & 15, cc = c & 31, ob = rr * 64 + cc * 2; return st * 1024 + (ob ^ (((ob >> 9) & 1) << 5)); }
__host__ __device__ __forceinline__ void stage_rc(int b, int& R, int& C) { const int st = b / 1024, sb = b % 1024, swz = sb ^ (((sb >> 9) & 1) << 5); R = (st >> 1) * 16 + swz / 64; C = (st & 1) * 32 + (swz % 64) / 2; }
__host__ __device__ __forceinline__ int perm32(int rho) { const int n = rho >> 4, i = rho & 15; return 8 * (i >> 2) + 4 * n + (i & 3); }

struct Unit { int pm, pn; };
struct Gemm { const bf16_t* A; const bf16_t* Bt; int M, N, K; };

struct StaticOrder {
    int nM, nN, nwg, G, c;
    __host__ __device__ void init(int M, int N, int G_, int c_) { nM = M / BM; nN = N / BM; nwg = nM * nN; G = G_; c = c_; }
    __host__ __device__ bool next(int i, Unit& u) const {
        const long L = (long)i * G + c; if (L >= nwg) return false;
        int wgid = (int)L; { const int q = nwg / NXCD, r = nwg % NXCD, xcd = wgid % NXCD, off = wgid / NXCD; wgid = (xcd < r ? xcd * (q + 1) : r * (q + 1) + (xcd - r) * q) + off; }
        const int nig = WGM * nN, gid = wgid / nig, fm = gid * WGM, gsz = (nM - fm) < WGM ? (nM - fm) : WGM;
        u.pm = fm + ((wgid % nig) % gsz); u.pn = (wgid % nig) / gsz; return true;
    }
    __device__ __forceinline__ void a_ready(const Unit&) const {}
    __device__ __forceinline__ void done(const Unit&) const {}
};

__device__ __forceinline__ unsigned cvt_pk_bf16(float lo, float hi) { unsigned r; asm volatile("v_cvt_pk_bf16_f32 %0, %1, %2" : "=v"(r) : "v"(lo), "v"(hi)); return r; }
typedef float f32x2 __attribute__((ext_vector_type(2)));
__device__ __forceinline__ f32x2 gelu_pk(f32x2 v) {
    const f32x2 av = __builtin_elementwise_abs(v), d = av * 0.2316418882f + 1.0f;
    f32x2 t; t.x = __builtin_amdgcn_rcpf(d.x); t.y = __builtin_amdgcn_rcpf(d.y);
    f32x2 q = t * 0.5307027145f + (-0.7265760135f); q = q * t + 0.7107068705f; q = q * t + (-0.142248368f); q = q * t + 0.127414796f; q = q * t;
    const f32x2 s = (v * v) * (-0.72134752044f);
    f32x2 e; e.x = __builtin_amdgcn_exp2f(s.x); e.y = __builtin_amdgcn_exp2f(s.y);
    const f32x2 m = v * (q * e), r = v - m;
    f32x2 o; o.x = v.x < 0.f ? m.x : r.x; o.y = v.y < 0.f ? m.y : r.y; return o;
}

struct EpiF32 {
    static constexpr bool PERM = false, AFTER_DRAIN = false, MID = false;
    float* C; int ldc; const float* bias;
    __device__ __forceinline__ void operator()(const f32x4 (&acc)[2][2][4][2], const Unit& u, int wr, int wc, int fr, int fq) const {
        const int row0 = u.pm * BM + wr * 64 + fr, col0 = u.pn * BM + wc * 32 + 4 * fq;
        f32x4 bv[2][2];
#pragma unroll
        for (int bj = 0; bj < 2; ++bj)
#pragma unroll
            for (int n = 0; n < 2; ++n) bv[bj][n] = bias ? *(const f32x4*)(bias + col0 + bj * HALF + n * 16) : (f32x4){0.f, 0.f, 0.f, 0.f};
#pragma unroll
        for (int ai = 0; ai < 2; ++ai)
#pragma unroll
            for (int m = 0; m < 4; ++m) { float* rowp = C + (size_t)(row0 + ai * HALF + m * 16) * ldc + col0;
#pragma unroll
                for (int bj = 0; bj < 2; ++bj)
#pragma unroll
                    for (int n = 0; n < 2; ++n) *(f32x4*)(rowp + bj * HALF + n * 16) = acc[ai][bj][m][n] + bv[bj][n]; }
    }
};
template <int ACT  > struct EpiBf16 {
    static constexpr bool PERM = true, AFTER_DRAIN = false, MID = false;
    bf16_t* O; int ldc; const float* bias; int split_cols; size_t split_stride;
    __device__ __forceinline__ void operator()(const f32x4 (&acc)[2][2][4][2], const Unit& u, int wr, int wc, int fr, int fq) const {
        const int row0 = u.pm * BM + wr * 64 + fr; int colt = u.pn * BM; bf16_t* base = O;
        if (split_cols) { const int t = colt / split_cols; base += (size_t)t * split_stride; colt -= t * split_cols; }
        const int col0 = colt + wc * 32 + 8 * fq, bcol0 = u.pn * BM + wc * 32 + 8 * fq;
        f32x4 bv[2][2];
#pragma unroll
        for (int bj = 0; bj < 2; ++bj)
#pragma unroll
            for (int n = 0; n < 2; ++n) bv[bj][n] = bias ? *(const f32x4*)(bias + bcol0 + bj * HALF + 4 * n) : (f32x4){0.f, 0.f, 0.f, 0.f};
#pragma unroll
        for (int ai = 0; ai < 2; ++ai)
#pragma unroll
            for (int m = 0; m < 4; ++m) { bf16_t* rowp = base + (size_t)(row0 + ai * HALF + m * 16) * ldc + col0;
#pragma unroll
                for (int bj = 0; bj < 2; ++bj) { f32x4 v0 = acc[ai][bj][m][0] + bv[bj][0], v1 = acc[ai][bj][m][1] + bv[bj][1];
                    if (ACT == 1) { f32x2 a = gelu_pk((f32x2){v0[0], v0[1]}), b = gelu_pk((f32x2){v0[2], v0[3]}), c = gelu_pk((f32x2){v1[0], v1[1]}), d = gelu_pk((f32x2){v1[2], v1[3]});
                        v0 = (f32x4){a.x, a.y, b.x, b.y}; v1 = (f32x4){c.x, c.y, d.x, d.y}; }
                    if (ACT == 2) {
#pragma unroll
                        for (int j = 0; j < 4; ++j) { v0[j] = 0.5f * v0[j] * (1.0f + erff(v0[j] * 0.70710678f)); v1[j] = 0.5f * v1[j] * (1.0f + erff(v1[j] * 0.70710678f)); } }
                    u32x4 w; w.x = cvt_pk_bf16(v0[0], v0[1]); w.y = cvt_pk_bf16(v0[2], v0[3]); w.z = cvt_pk_bf16(v1[0], v1[1]); w.w = cvt_pk_bf16(v1[2], v1[3]);
                    *(u32x4*)(rowp + bj * HALF) = w; } }
    }
};
template <class Epi, class Sched>
__device__ __forceinline__ void gemm_phase(PG8_LAS unsigned char* lds, const Gemm g, const Sched& S, const Epi& E) {
    int tid_l = threadIdx.x; asm volatile("" : "+v"(tid_l));
    const int tid = tid_l, wid = __builtin_amdgcn_readfirstlane(tid >> 6), lane = tid & 63, wr = wid >> 2, wc = wid & 3, fr = lane & 15, fq = lane >> 4;
    const int K = g.K, nt = K / BK;
    unsigned voffA[2], voffB[2];
#pragma unroll
    for (int i = 0; i < 2; ++i) { int R, C; stage_rc(tid * 16 + i * 8192, R, C); const int Rb = Epi::PERM ? ((R & ~31) + perm32(R & 31)) : R;
        voffA[i] = (unsigned)(R * K + C) * 2u; voffB[i] = (unsigned)(Rb * K + C) * 2u; }
    const size_t kstep = (size_t)(BK * 2);
    const size_t hstep = (size_t)HALF * K * 2;
    const size_t tstep = 2 * hstep;
    const unsigned ldsw = (unsigned)wid * 1024u;
    const int aoff = lds_byte(wr * 64 + fr, fq * 8), boff = lds_byte(wc * 32 + fr, fq * 8);
#define PG8_SA(b, h) (((b) * 2 + (h)) * HTB)
#define PG8_SB(b, h) ((4 + (b) * 2 + (h)) * HTB)
#define PG8_STAGE(bufoff, gbase, voff) do { _Pragma("unroll") for (int _i = 0; _i < 2; ++_i) \
        __builtin_amdgcn_global_load_lds((const unsigned*)((const char*)(gbase) + (voff)[_i]), (PG8_LAS unsigned*)(lds + (bufoff) + ldsw + _i * 8192), 16, 0, 0); } while (0)
#define PG8_LDA(dst, b, h) do { _Pragma("unroll") for (int m = 0; m < 4; ++m) _Pragma("unroll") for (int k = 0; k < 2; ++k) dst[m][k] = *(const PG8_LAS bf16x8*)(lds + PG8_SA(b, h) + aoff + m * 2048 + k * 1024); } while (0)
#define PG8_LDB(dst, b, h) do { _Pragma("unroll") for (int n = 0; n < 2; ++n) _Pragma("unroll") for (int k = 0; k < 2; ++k) dst[n][k] = *(const PG8_LAS bf16x8*)(lds + PG8_SB(b, h) + boff + n * 2048 + k * 1024); } while (0)
#define PG8_MMA(ai, bj, At, Bt) do { __builtin_amdgcn_s_setprio(1); _Pragma("unroll") for (int m = 0; m < 4; ++m) _Pragma("unroll") for (int n = 0; n < 2; ++n) _Pragma("unroll") for (int k = 0; k < 2; ++k) \
        acc[ai][bj][m][n] = __builtin_amdgcn_mfma_f32_16x16x32_bf16(Bt[n][k], At[m][k], acc[ai][bj][m][n], 0, 0, 0); __builtin_amdgcn_s_setprio(0); } while (0)
#define PG8_WAIT_V(n) asm volatile("s_waitcnt vmcnt(" #n ")" ::: "memory")
#define PG8_WAIT_L(n) asm volatile("s_waitcnt lgkmcnt(" #n ")" ::: "memory")
#define PG8_BAR __builtin_amdgcn_s_barrier()
#define PG8_SCHED __builtin_amdgcn_sched_barrier(0)
    Unit cur, nxt; int ui = 0;
    if (!S.next(0, cur)) return;
    f32x4 acc[2][2][4][2];
#pragma unroll
    for (int a = 0; a < 2; ++a)
#pragma unroll
        for (int b = 0; b < 2; ++b)
#pragma unroll
            for (int m = 0; m < 4; ++m)
#pragma unroll
                for (int n = 0; n < 2; ++n) acc[a][b][m][n] = (f32x4){0.f, 0.f, 0.f, 0.f};
    bf16x8 At[4][2], B0[2][2], B1[2][2];
    const char* cA = (const char*)g.A + (size_t)cur.pm * tstep; const char* cB = (const char*)g.Bt + (size_t)cur.pn * tstep;
    S.a_ready(cur);
    PG8_STAGE(PG8_SB(0, 0), cB, voffB); PG8_STAGE(PG8_SA(0, 0), cA, voffA); PG8_STAGE(PG8_SB(0, 1), cB + hstep, voffB); PG8_STAGE(PG8_SA(0, 1), cA + hstep, voffA);
    if (wr == 1) PG8_BAR;
    PG8_WAIT_V(4); PG8_BAR;
    PG8_STAGE(PG8_SB(1, 0), cB + kstep, voffB); PG8_STAGE(PG8_SA(1, 0), cA + kstep, voffA); PG8_STAGE(PG8_SB(1, 1), cB + hstep + kstep, voffB);
    PG8_WAIT_V(6); PG8_BAR;
    for (;;) {
        const bool has_next = S.next(ui + 1, nxt);
        const char* nA = has_next ? (const char*)g.A + (size_t)nxt.pm * tstep : cA; const char* nB = has_next ? (const char*)g.Bt + (size_t)nxt.pn * tstep : cB;
        for (int t = 0; t < nt; t += 2) {
            if constexpr (Epi::MID) {
                if (t == (nt >> 1)) {
                    E.mid(acc, cur, wr, wc, fr, fq);
#pragma unroll
                    for (int a = 0; a < 2; ++a)
#pragma unroll
                        for (int b = 0; b < 2; ++b)
#pragma unroll
                            for (int m = 0; m < 4; ++m)
#pragma unroll
                                for (int n = 0; n < 2; ++n) acc[a][b][m][n] = (f32x4){0.f, 0.f, 0.f, 0.f};
                }
            }
            const bool last = (t == nt - 2);
            const char* a1 = cA + (size_t)(t + 1) * kstep;
            const char* a2 = last ? nA : cA + (size_t)(t + 2) * kstep; const char* b2 = last ? nB : cB + (size_t)(t + 2) * kstep;
            const char* a3 = a2 + kstep; const char* b3 = b2 + kstep;
            if (last && has_next) S.a_ready(nxt);
            PG8_LDB(B0, 0, 0); PG8_SCHED; PG8_LDA(At, 0, 0); PG8_STAGE(PG8_SA(1, 1), a1 + hstep, voffA);
            PG8_WAIT_L(8); PG8_BAR; PG8_WAIT_L(0); PG8_MMA(0, 0, At, B0); PG8_BAR; PG8_SCHED;
            PG8_LDB(B1, 0, 1); PG8_STAGE(PG8_SB(0, 0), b2, voffB);
            PG8_BAR; PG8_WAIT_L(0); PG8_MMA(0, 1, At, B1); PG8_BAR;
            PG8_LDA(At, 0, 1); PG8_STAGE(PG8_SA(0, 0), a2, voffA);
            PG8_BAR; PG8_WAIT_L(0); PG8_MMA(1, 0, At, B0); PG8_BAR; PG8_SCHED;
            PG8_STAGE(PG8_SB(0, 1), b2 + hstep, voffB);
            PG8_WAIT_V(6); PG8_BAR; PG8_MMA(1, 1, At, B1); PG8_BAR;
            PG8_LDB(B0, 1, 0); PG8_SCHED; PG8_LDA(At, 1, 0); PG8_STAGE(PG8_SA(0, 1), a2 + hstep, voffA);
            PG8_WAIT_L(8); PG8_BAR; PG8_WAIT_L(0); PG8_MMA(0, 0, At, B0); PG8_BAR; PG8_SCHED;
            PG8_LDB(B1, 1, 1); PG8_STAGE(PG8_SB(1, 0), b3, voffB);
            PG8_BAR; PG8_WAIT_L(0); PG8_MMA(0, 1, At, B1); PG8_BAR;
            PG8_LDA(At, 1, 1); PG8_STAGE(PG8_SA(1, 0), a3, voffA);
            PG8_BAR; PG8_WAIT_L(0); PG8_MMA(1, 0, At, B0); PG8_BAR; PG8_SCHED;
            PG8_STAGE(PG8_SB(1, 1), b3 + hstep, voffB);
            PG8_WAIT_V(6); PG8_BAR; PG8_MMA(1, 1, At, B1); PG8_BAR;
        }
        if constexpr (!Epi::AFTER_DRAIN) { E(acc, cur, wr, wc, fr, fq); S.done(cur); }
        if (!has_next) break;
#pragma unroll
        for (int a = 0; a < 2; ++a)
#pragma unroll
            for (int b = 0; b < 2; ++b)
#pragma unroll
                for (int m = 0; m < 4; ++m)
#pragma unroll
                    for (int n = 0; n < 2; ++n) acc[a][b][m][n] = (f32x4){0.f, 0.f, 0.f, 0.f};
        cur = nxt; cA = nA; cB = nB; ++ui;
    }
    PG8_WAIT_V(0);
    if (wr == 0) PG8_BAR;
    PG8_BAR;
    if constexpr (Epi::AFTER_DRAIN) { E.fused(acc, cur, wr, wc, fr, fq, lds, wid, lane); S.done(cur); }
#undef PG8_SA
#undef PG8_SB
#undef PG8_STAGE
#undef PG8_LDA
#undef PG8_LDB
#undef PG8_MMA
#undef PG8_WAIT_V
#undef PG8_WAIT_L
#undef PG8_BAR
#undef PG8_SCHED
}
}
#define XB_TMO      128
#define XB_XCNT(j)  (256  + 64 * (j))
#define XB_XSUB(j)  (1280 + 64 * (j))
#define XB_XGEN(j)  (2304 + 64 * (j))
#define XB_TOP      3328
#define XB_TOPGEN   3392
#define XCD_BAR_WORDS 3456
#define XB_SPIN_CAP (1u << 18)
#define LAS __attribute__((address_space(3)))

__device__ __forceinline__ unsigned xb_ld(unsigned* p)              { return __hip_atomic_load(p, __ATOMIC_RELAXED, __HIP_MEMORY_SCOPE_AGENT); }
__device__ __forceinline__ unsigned xb_add(unsigned* p, unsigned v) { return __hip_atomic_fetch_add(p, v, __ATOMIC_RELAXED, __HIP_MEMORY_SCOPE_AGENT); }
__device__ __forceinline__ unsigned xb_xcc_id() { return (unsigned)__builtin_amdgcn_s_getreg((3 << 11) | 20) & 0xFu; }
#define XB_SPIN(cond, bar) do { unsigned _sp = 0; while (cond) { __builtin_amdgcn_s_sleep(1); \
    if ((++_sp & 255u) == 0u) { if (xb_ld(&(bar)[XB_TMO])) break; if (_sp > XB_SPIN_CAP) { atomicAdd(&(bar)[XB_TMO], 1u); break; } } } } while (0)

struct XcdBarrier {
    unsigned* bar; unsigned x;
    volatile LAS unsigned* st;
};

__device__ __forceinline__ XcdBarrier xcd_barrier_post(unsigned* bar, volatile LAS unsigned* st) {
    XcdBarrier b; b.bar = bar; b.x = xb_xcc_id(); b.st = st;
    if (threadIdx.x == 0) (void)xb_add(&bar[XB_XCNT(b.x)], 1u);
    return b;
}
__device__ __forceinline__ void xcd_barrier_complete(unsigned* bar, unsigned x, unsigned& nloc, unsigned& nx) {
    const unsigned G = gridDim.x * gridDim.y * gridDim.z;
    unsigned sum, cnt, mine, sp = 0u;
    for (;;) {
        sum = 0u; cnt = 0u; mine = 0u;
        unsigned cc[16];
#pragma unroll
        for (unsigned j = 0; j < 16; ++j) cc[j] = xb_ld(&bar[XB_XCNT(j)]);
#pragma unroll
        for (unsigned j = 0; j < 16; ++j) { const unsigned c = cc[j]; sum += c; cnt += (c > 0u) ? 1u : 0u; mine = (j == x) ? c : mine; }
        if (sum == G) break;
        __builtin_amdgcn_s_sleep(1);
        if ((++sp & 255u) == 0u) { if (xb_ld(&bar[XB_TMO])) break; if (sp > XB_SPIN_CAP) { atomicAdd(&bar[XB_TMO], 1u); break; } }
    }
    nloc = mine > 0u ? mine : 1u; nx = cnt > 0u ? cnt : 1u;
}

__device__ __forceinline__ void xcd_barrier(const XcdBarrier& b) {
    asm volatile("s_waitcnt vmcnt(0)" ::: "memory");
    __syncthreads();
    if (threadIdx.x == 0) {
        unsigned* bar = b.bar;
        __builtin_amdgcn_s_waitcnt(0);
        unsigned nloc = b.st[0], nx = b.st[1];
        if (nloc == 0u) { xcd_barrier_complete(bar, b.x, nloc, nx); b.st[0] = nloc; b.st[1] = nx; }
        const unsigned old = xb_add(&bar[XB_XSUB(b.x)], 1u);
        const unsigned gen = old / nloc;
        if (old + 1u == (gen + 1u) * nloc) {
            __builtin_amdgcn_fence(__ATOMIC_RELEASE, "agent");
            asm volatile("s_waitcnt vmcnt(0)" ::: "memory");
            const unsigned og = xb_add(&bar[XB_TOP], 1u);
            const unsigned tg = og / nx;
            if (og + 1u == (tg + 1u) * nx) xb_add(&bar[XB_TOPGEN], 1u);
            else XB_SPIN(xb_ld(&bar[XB_TOPGEN]) == tg, bar);
            __builtin_amdgcn_fence(__ATOMIC_ACQUIRE, "agent");
            xb_add(&bar[XB_XGEN(b.x)], 1u);
            asm volatile("s_waitcnt vmcnt(0)" ::: "memory");
        } else {
            XB_SPIN(xb_ld(&bar[XB_XGEN(b.x)]) == gen, bar);
            __builtin_amdgcn_fence(__ATOMIC_ACQUIRE, "agent");
            asm volatile("s_waitcnt vmcnt(0)" ::: "memory");
        }
    }
    __syncthreads();
}


#define DI __device__ __forceinline__
typedef unsigned short u16;
typedef short bf16x8 __attribute__((ext_vector_type(8)));
typedef short s16x4 __attribute__((ext_vector_type(4)));
typedef float f32x2v __attribute__((ext_vector_type(2)));
typedef float f32x4 __attribute__((ext_vector_type(4)));
typedef float f32x16 __attribute__((ext_vector_type(16)));
typedef unsigned u32x4 __attribute__((ext_vector_type(4)));
typedef unsigned u32x2 __attribute__((ext_vector_type(2)));
typedef __bf16 bf16x2n __attribute__((ext_vector_type(2)));
#define ST(p) (DRY ? (decltype(p))(dummy + (size_t)tid * 16) : (p))
#define MFMA32(a, b, c) __builtin_amdgcn_mfma_f32_32x32x16_bf16((a), (b), (c), 0, 0, 0)

constexpr int DM = 1024, NB = 8, SEQ = 4096, CTXL = 256, NLAT = NB * SEQ, NCTX = NB * CTXL, NROW = NLAT + NCTX, INC = 3584;
constexpr int NKEY = SEQ + CTXL, NCHUNK = NROW / 64, FK = 4096, FKC = 512;
constexpr float EPSV = 1e-6f;
constexpr float QSCALE = 0.125f * 1.4426950408889634f;
constexpr int C_CB = 0, C_CC = 256, C_CX = 512, C_CZ = 768, C_AQ = 1024, C_AK = 1280, C_AV = 1408, C_AZ = 1536,
              C_HQ = 1792, C_HF0 = 2048, C_HF1 = 2304, C_HI = 2560, C_HZ = 2816, C_FU = 3072, C_FZ = 3328;

constexpr size_t al256(size_t x) { return (x + 255) & ~(size_t)255; }
constexpr size_t WS_CTR = 0;
constexpr size_t WS_BAR = 4096;
constexpr size_t WS_CTL_BYTES = 32768;
constexpr size_t WS_E = WS_CTL_BYTES;
constexpr size_t WS_MOD = WS_E + 8192;
constexpr size_t WS_ROPE = WS_MOD + al256((size_t)2 * 9 * 3072 * 4);
constexpr size_t WS_WIN = WS_ROPE + (size_t)4096 * 32 * 2 * 4;
constexpr size_t WS_WOUT = WS_WIN + (size_t)2 * INC * DM * 2;
constexpr size_t WS_CS = WS_WOUT + (size_t)2 * DM * DM * 2;
constexpr size_t WS_CSC = WS_CS + (size_t)SEQ * FK * 2;
constexpr size_t WS_UT = WS_CSC + (size_t)CTXL * FKC * 2;
constexpr size_t WS_UTC = WS_UT + (size_t)2048 * FK * 2;
constexpr size_t WS_VT = WS_UTC + (size_t)2048 * FKC * 2;
constexpr size_t WS_G = WS_VT + (size_t)16 * 64 * NKEY * 2;
constexpr size_t WS_DEC = WS_G + (size_t)NCHUNK * 8 * 4096 * 2;
constexpr size_t WS_EREF = WS_DEC + (size_t)NCHUNK * 8 * 64 * 4;
constexpr size_t WS_VTH = WS_EREF + (size_t)NCHUNK * 8 * 64 * 4;
constexpr size_t WS_HC = WS_VTH + (size_t)NCHUNK * 4 * 4096 * 2;
constexpr size_t WS_Y = WS_HC + (size_t)NCTX * DM * 4;
constexpr size_t WS_Z = WS_Y + (size_t)NROW * DM * 2;
constexpr size_t WS_STASH = WS_Z + (size_t)NROW * INC * 2;
constexpr size_t WS_END = WS_STASH + (size_t)64 * 262144;

constexpr int LDS_CTL = 147456;
constexpr int LDS_BYTES = LDS_CTL + 1024;

struct Params {
    const float* x; const float* c; const float* ctx; const float* c_ctx; const float* norm_g; const float* w_mod; const float* b_mod;
    const float* w_in; const float* conv_w; const float* q_g; const float* k_g; const float* hgrn_lb; const float* hg_g; const float* w_out; const float* final_g;
    float* out; unsigned char* ws;
    int ph_lo, ph_hi;
};

DI int tidx() { int t = threadIdx.x; asm volatile("" : "+v"(t)); return t; }
template <class T> DI T* relaunder(T* p) {
    unsigned long long v = (unsigned long long)p;
    asm volatile("" : "+s"(v));
    return (T*)(__attribute__((address_space(1))) T*)v;
}
DI Params launder(Params Q) {
    Q.x = relaunder(Q.x); Q.c = relaunder(Q.c); Q.ctx = relaunder(Q.ctx); Q.c_ctx = relaunder(Q.c_ctx); Q.norm_g = relaunder(Q.norm_g); Q.w_mod = relaunder(Q.w_mod);
    Q.b_mod = relaunder(Q.b_mod); Q.w_in = relaunder(Q.w_in); Q.conv_w = relaunder(Q.conv_w); Q.q_g = relaunder(Q.q_g); Q.k_g = relaunder(Q.k_g); Q.hgrn_lb = relaunder(Q.hgrn_lb);
    Q.hg_g = relaunder(Q.hg_g); Q.w_out = relaunder(Q.w_out); Q.final_g = relaunder(Q.final_g); Q.out = relaunder(Q.out); Q.ws = relaunder(Q.ws);
    return Q;
}
DI float bf2f(u16 v) { return __uint_as_float((unsigned)v << 16); }
DI float bf2f_s(short v) { return __uint_as_float((unsigned)(u16)v << 16); }
DI unsigned pack2(float lo, float hi) { f32x2v v = {lo, hi}; bf16x2n b = __builtin_convertvector(v, bf16x2n); return __builtin_bit_cast(unsigned, b); }
DI u16 f2bf(float f) { return (u16)(pack2(f, 0.f) & 0xffffu); }
DI bf16x8 ld8(const u16* p) { return *(const bf16x8*)p; }
DI s16x4 ld4(const u16* p) { return *(const s16x4*)p; }
DI float silu_f(float x) { return x * __builtin_amdgcn_rcpf(1.0f + __expf(-x)); }
DI bf16x8 pack8(float a0, float a1, float a2, float a3, float a4, float a5, float a6, float a7) {
    u32x4 p; p.x = pack2(a0, a1); p.y = pack2(a2, a3); p.z = pack2(a4, a5); p.w = pack2(a6, a7); return __builtin_bit_cast(bf16x8, p);
}
DI int crow(int reg, int h) { return (reg & 3) + 8 * (reg >> 2) + 4 * h; }
DI f32x16 zero16() { f32x16 z; for (int i = 0; i < 16; ++i) z[i] = 0.f; return z; }

struct EpiRes {
    static constexpr bool PERM = true, AFTER_DRAIN = false, MID = false;
    const float* src32; const u16* src16; u16* dst; const float* mod; int use16;
    DI void operator()(const pg8::f32x4 (&acc)[2][2][4][2], const pg8::Unit& u, int wr, int wc, int fr, int fq) const {
        const float* gate = mod + (u.pm >> 4) * 3072 + 2048;
        const int row0 = u.pm * 256 + wr * 64 + fr, col0 = u.pn * 256 + wc * 32 + 8 * fq;
        f32x4 gv[2][2];
#pragma unroll
        for (int bj = 0; bj < 2; ++bj)
#pragma unroll
            for (int n = 0; n < 2; ++n) gv[bj][n] = *(const f32x4*)(gate + col0 + bj * 128 + 4 * n);
        if (use16) {
#pragma unroll
            for (int ai = 0; ai < 2; ++ai) {
                bf16x8 t[4][2];
#pragma unroll
                for (int m = 0; m < 4; ++m)
#pragma unroll
                    for (int bj = 0; bj < 2; ++bj) t[m][bj] = ld8(src16 + (size_t)(row0 + ai * 128 + m * 16) * DM + col0 + bj * 128);
#pragma unroll
                for (int m = 0; m < 4; ++m)
#pragma unroll
                    for (int bj = 0; bj < 2; ++bj) {
                        const f32x4 a0 = acc[ai][bj][m][0], a1 = acc[ai][bj][m][1], g0 = gv[bj][0], g1 = gv[bj][1]; const bf16x8 tt = t[m][bj];
                        *(bf16x8*)(dst + (size_t)(row0 + ai * 128 + m * 16) * DM + col0 + bj * 128) =
                            pack8(bf2f_s(tt[0]) + g0[0] * a0[0], bf2f_s(tt[1]) + g0[1] * a0[1], bf2f_s(tt[2]) + g0[2] * a0[2], bf2f_s(tt[3]) + g0[3] * a0[3],
                                  bf2f_s(tt[4]) + g1[0] * a1[0], bf2f_s(tt[5]) + g1[1] * a1[1], bf2f_s(tt[6]) + g1[2] * a1[2], bf2f_s(tt[7]) + g1[3] * a1[3]);
                    }
            }
        } else {
#pragma unroll
            for (int ai = 0; ai < 2; ++ai)
#pragma unroll
                for (int mh = 0; mh < 2; ++mh) {
                    f32x4 r[2][2][2];
#pragma unroll
                    for (int m = 0; m < 2; ++m)
#pragma unroll
                        for (int bj = 0; bj < 2; ++bj)
#pragma unroll
                            for (int n = 0; n < 2; ++n) r[m][bj][n] = *(const f32x4*)(src32 + (size_t)(row0 + ai * 128 + (2 * mh + m) * 16) * DM + col0 + bj * 128 + 4 * n);
#pragma unroll
                    for (int m = 0; m < 2; ++m)
#pragma unroll
                        for (int bj = 0; bj < 2; ++bj) {
                            const f32x4 v0 = r[m][bj][0] + gv[bj][0] * acc[ai][bj][2 * mh + m][0], v1 = r[m][bj][1] + gv[bj][1] * acc[ai][bj][2 * mh + m][1];
                            *(bf16x8*)(dst + (size_t)(row0 + ai * 128 + (2 * mh + m) * 16) * DM + col0 + bj * 128) = pack8(v0[0], v0[1], v0[2], v0[3], v1[0], v1[1], v1[2], v1[3]);
                        }
                }
        }
    }
};
struct EpiFour {
    static constexpr bool PERM = true, AFTER_DRAIN = false, MID = false;
    const u16* Z; u16* Y; int isctx; float scale; const float* E;
    DI void operator()(const pg8::f32x4 (&acc)[2][2][4][2], const pg8::Unit& u, int wr, int wc, int fr, int fq) const {
        const int b = u.pn;
        const int rbase = (isctx ? NLAT + b * CTXL : b * SEQ) + u.pm * 256 + wr * 64 + fr;
        const int ch0 = wc * 32 + 8 * fq;
        const float esg = (fr & 1) ? -1.0f : 1.0f;
        f32x4 e0[2], e1[2];
#pragma unroll
        for (int bj = 0; bj < 2; ++bj) {
            if (E) { e0[bj] = *(const f32x4*)(E + b * 256 + ch0 + bj * 128) * esg; e1[bj] = *(const f32x4*)(E + b * 256 + ch0 + bj * 128 + 4) * esg; }
            else { e0[bj] = (f32x4){0.f, 0.f, 0.f, 0.f}; e1[bj] = e0[bj]; }
        }
#pragma unroll
        for (int ai = 0; ai < 2; ++ai) {
            bf16x8 zz[4][2];
#pragma unroll
            for (int m = 0; m < 4; ++m)
#pragma unroll
                for (int bj = 0; bj < 2; ++bj) zz[m][bj] = ld8(Z + (size_t)(rbase + ai * 128 + m * 16) * INC + C_FZ + ch0 + bj * 128);
#pragma unroll
            for (int m = 0; m < 4; ++m) {
                const size_t row = (size_t)(rbase + ai * 128 + m * 16);
#pragma unroll
                for (int bj = 0; bj < 2; ++bj) {
                    const int ch = ch0 + bj * 128;
                    const bf16x8 z = zz[m][bj];
                    const f32x4 v0 = acc[ai][bj][m][0] + e0[bj], v1 = acc[ai][bj][m][1] + e1[bj];
                    u32x4 w;
                    w.x = pack2(v0[0] * scale * silu_f(bf2f_s(z[0])), v0[1] * scale * silu_f(bf2f_s(z[1])));
                    w.y = pack2(v0[2] * scale * silu_f(bf2f_s(z[2])), v0[3] * scale * silu_f(bf2f_s(z[3])));
                    w.z = pack2(v1[0] * scale * silu_f(bf2f_s(z[4])), v1[1] * scale * silu_f(bf2f_s(z[5])));
                    w.w = pack2(v1[2] * scale * silu_f(bf2f_s(z[6])), v1[3] * scale * silu_f(bf2f_s(z[7])));
                    *(u32x4*)(Y + row * DM + 768 + ch) = w;
                }
            }
        }
    }
};

struct EpiFourM {
    static constexpr bool PERM = true, AFTER_DRAIN = false, MID = true;
    const u16* Z; u16* Y; float scale; const float* E; f32x4* stash;
    DI void mid(const pg8::f32x4 (&acc)[2][2][4][2], const pg8::Unit&, int wr, int wc, int fr, int fq) const {
        f32x4* p = stash + ((wr * 4 + wc) * 64 + fq * 16 + fr);
#pragma unroll
        for (int ai = 0; ai < 2; ++ai)
#pragma unroll
            for (int m = 0; m < 4; ++m)
#pragma unroll
                for (int bj = 0; bj < 2; ++bj)
#pragma unroll
                    for (int n = 0; n < 2; ++n) { *p = acc[ai][bj][m][n]; p += 512; asm volatile("" : "+v"(p)); }
    }
    DI void operator()(const pg8::f32x4 (&acc)[2][2][4][2], const pg8::Unit& u, int wr, int wc, int fr, int fq) const {
        const f32x4* p = stash + ((wr * 4 + wc) * 64 + fq * 16 + fr);
        const int b = u.pn, tp0 = u.pm * 256 + wr * 64 + fr, ch0 = wc * 32 + 8 * fq;
        const float esg = (fr & 1) ? -1.0f : 1.0f;
        f32x4 e0[2], e1[2];
#pragma unroll
        for (int bj = 0; bj < 2; ++bj) { e0[bj] = *(const f32x4*)(E + b * 256 + ch0 + bj * 128) * esg; e1[bj] = *(const f32x4*)(E + b * 256 + ch0 + bj * 128 + 4) * esg; }
#pragma unroll
        for (int ai = 0; ai < 2; ++ai)
#pragma unroll
            for (int m = 0; m < 4; ++m) {
                const int tp = tp0 + ai * 128 + m * 16;
                f32x4 c[2][2]; bf16x8 z1[2], z2[2];
#pragma unroll
                for (int bj = 0; bj < 2; ++bj) {
                    c[bj][0] = p[0]; c[bj][1] = p[512]; p += 1024; asm volatile("" : "+v"(p));
                    z1[bj] = ld8(Z + (size_t)(b * SEQ + tp) * INC + C_FZ + ch0 + bj * 128);
                    z2[bj] = ld8(Z + (size_t)(b * SEQ + (tp > 0 ? SEQ - tp : 0)) * INC + C_FZ + ch0 + bj * 128);
                }
#pragma unroll
                for (int bj = 0; bj < 2; ++bj) {
                    const int ch = ch0 + bj * 128;
                    const f32x4 s0 = acc[ai][bj][m][0], s1 = acc[ai][bj][m][1];
                    const f32x4 p0 = (c[bj][0] + s0 + e0[bj]) * scale, p1 = (c[bj][1] + s1 + e1[bj]) * scale;
                    const f32x4 q0 = (c[bj][0] - s0 + e0[bj]) * scale, q1 = (c[bj][1] - s1 + e1[bj]) * scale;
                    const bf16x8 za = z1[bj], zb = z2[bj];
                    *(bf16x8*)(Y + (size_t)(b * SEQ + tp) * DM + 768 + ch) =
                        pack8(p0[0] * silu_f(bf2f_s(za[0])), p0[1] * silu_f(bf2f_s(za[1])), p0[2] * silu_f(bf2f_s(za[2])), p0[3] * silu_f(bf2f_s(za[3])),
                              p1[0] * silu_f(bf2f_s(za[4])), p1[1] * silu_f(bf2f_s(za[5])), p1[2] * silu_f(bf2f_s(za[6])), p1[3] * silu_f(bf2f_s(za[7])));
                    if (tp > 0)
                        *(bf16x8*)(Y + (size_t)(b * SEQ + SEQ - tp) * DM + 768 + ch) =
                            pack8(q0[0] * silu_f(bf2f_s(zb[0])), q0[1] * silu_f(bf2f_s(zb[1])), q0[2] * silu_f(bf2f_s(zb[2])), q0[3] * silu_f(bf2f_s(zb[3])),
                                  q1[0] * silu_f(bf2f_s(zb[4])), q1[1] * silu_f(bf2f_s(zb[5])), q1[2] * silu_f(bf2f_s(zb[6])), q1[3] * silu_f(bf2f_s(zb[7])));
                }
            }
    }
};

constexpr int P0_MOD = 96, P0_WIN0 = P0_MOD + 896, P0_WIN = P0_MOD + 1792, P0_WOUT = P0_WIN + 512, P0_CS = P0_WOUT + 128, P0_END = P0_CS + 1 + 1;
DI void p0_transpose(const float* W, u16* WT, int K, int N, int kt, int nt, float* tile) {
    const int tid = tidx();
#pragma unroll
    for (int i = 0; i < 2; ++i) {
        const int idx = tid + i * 512, r = idx >> 4, c4 = (idx & 15) * 4;
        const f32x4 v = *(const f32x4*)(W + (size_t)(kt * 64 + r) * N + nt * 64 + c4);
        tile[r * 65 + c4 + 0] = v[0]; tile[r * 65 + c4 + 1] = v[1]; tile[r * 65 + c4 + 2] = v[2]; tile[r * 65 + c4 + 3] = v[3];
    }
    __syncthreads();
    const int n = tid >> 3, ks = tid & 7;
    float v[8];
#pragma unroll
    for (int j = 0; j < 8; ++j) v[j] = tile[(ks * 8 + j) * 65 + n];
    *(bf16x8*)(WT + (size_t)(nt * 64 + n) * K + kt * 64 + ks * 8) = pack8(v[0], v[1], v[2], v[3], v[4], v[5], v[6], v[7]);
    __syncthreads();
}

DI void p0_prologue(const Params& P, unsigned char* lds, int lo_it, int hi_it, int first, int stride) {
    const int tid = tidx();
    float* fl = (float*)lds;
    unsigned char* ws = P.ws;
    constexpr int N_WIN = 2 * 16 * 56, N_WOUT = 2 * 16 * 16, N_CS = 128, N_CSC = 1, N_ROPE = 1, N_MOD = 96;
    constexpr int T0 = N_MOD, T1 = T0 + N_WIN, T2 = T1 + N_WOUT, T3 = T2 + N_CS, T4 = T3 + N_CSC, T5 = T4 + N_ROPE;
    (void)T5;
    for (int it = lo_it + first; it < hi_it; it += stride) {
        if (it < T0) {
            const int l = it / 48, chunk = it % 48;
            float* act = fl;
            float* red = fl + 9 * 1024;
            for (int i = tid; i < 9 * 1024; i += 512) { const int m = i >> 10, k = i & 1023; const float v = m < 8 ? P.c[m * 1024 + k] : P.c_ctx[k]; act[i] = silu_f(v); }
            __syncthreads();
            const int kp = tid >> 6, col = tid & 63, c0 = chunk * 64 + col;
            float acc[9];
#pragma unroll
            for (int m = 0; m < 9; ++m) acc[m] = 0.f;
            const float* wp = P.w_mod + (size_t)l * 1024 * 3072 + c0;
#pragma unroll 1
            for (int k0 = kp * 128; k0 < kp * 128 + 128; k0 += 16) {
                float w[16];
#pragma unroll
                for (int j = 0; j < 16; ++j) w[j] = wp[(size_t)(k0 + j) * 3072];
                asm volatile("" ::: "memory");
#pragma unroll
                for (int j = 0; j < 16; ++j)
#pragma unroll
                    for (int m = 0; m < 9; ++m) acc[m] += act[m * 1024 + k0 + j] * w[j];
            }
#pragma unroll
            for (int m = 0; m < 9; ++m) red[(kp * 9 + m) * 64 + col] = acc[m];
            __syncthreads();
            for (int i = tid; i < 9 * 64; i += 512) {
                const int m = i >> 6, cc = i & 63; float s = 0.f;
#pragma unroll
                for (int q = 0; q < 8; ++q) s += red[(q * 9 + m) * 64 + cc];
                ((float*)(ws + WS_MOD))[(l * 9 + m) * 3072 + chunk * 64 + cc] = s + P.b_mod[l * 3072 + chunk * 64 + cc];
            }
            __syncthreads();
        } else if (it < T1) {
            const int j = it - T0, l = j / 896, r = j % 896, kt = r / 56, nt = r % 56;
            p0_transpose(P.w_in + (size_t)l * DM * INC, (u16*)(ws + WS_WIN) + (size_t)l * INC * DM, DM, INC, kt, nt, fl);
        } else if (it < T2) {
            const int j = it - T1, l = j / 256, r = j % 256, kt = r / 16, nt = r % 16;
            p0_transpose(P.w_out + (size_t)l * DM * DM, (u16*)(ws + WS_WOUT) + (size_t)l * DM * DM, DM, DM, kt, nt, fl);
        } else if (it < T4) {
            float* tab = fl;
            for (int i = tid; i < 4096; i += 512) tab[i] = cospif((float)i * (1.0f / 2048.0f));
            __syncthreads();
            if (it < T3) {
                const int r0 = (it - T2) * 16;
                u16* CS = (u16*)(ws + WS_CS);
                for (int i = tid; i < 16 * 512; i += 512) {
                    const int tp = r0 + (i >> 9), k0 = (i & 511) * 8;
                    float v[8];
#pragma unroll
                    for (int j = 0; j < 8; ++j) {
                        const int k = k0 + j;
                        if (k < 2048) v[j] = tab[(k * tp) & 4095];
                        else v[j] = -tab[(((k - 2048) * tp) - 1024) & 4095];
                    }
                    *(bf16x8*)(CS + (size_t)tp * FK + k0) = pack8(v[0], v[1], v[2], v[3], v[4], v[5], v[6], v[7]);
                }
            } else {
                u16* CSC = (u16*)(ws + WS_CSC);
                for (int i = tid; i < 256 * 64; i += 512) {
                    const int tp = i >> 6, k0 = (i & 63) * 8;
                    float v[8];
#pragma unroll
                    for (int j = 0; j < 8; ++j) {
                        const int k = k0 + j;
                        if (k < 256) v[j] = tab[((k * tp) & 255) * 16];
                        else v[j] = -tab[((((k - 256) * tp) & 255) * 16 - 1024) & 4095];
                    }
                    *(bf16x8*)(CSC + (size_t)tp * FKC + k0) = pack8(v[0], v[1], v[2], v[3], v[4], v[5], v[6], v[7]);
                }
            }
            __syncthreads();
        } else {
            float* rope = (float*)(ws + WS_ROPE);
            for (int i = tid; i < 64 * 16; i += 512) {
                const int v = i >> 4, j = i & 15;
                const float freq = powf(10000.0f, -(float)j / 16.0f);
                const float ang = (float)v * freq;
                rope[i * 2] = cosf(ang);
                rope[i * 2 + 1] = sinf(ang);
            }
        }
    }
}

DI void phase_a(const Params& P, int layer) {
    const int tid_ = tidx(); const int lane = tid_ & 63, wave = tid_ >> 6;
    u16* A = (u16*)(P.ws + WS_Y);
    const float* modl = (const float*)(P.ws + WS_MOD) + layer * 9 * 3072;
    const float* g = P.norm_g + layer * DM;
    for (int row = blockIdx.x * 8 + wave; row < NROW; row += gridDim.x * 8) {
        const bool isctx = row >= NLAT;
        const float* md = modl + (isctx ? 8 : row >> 12) * 3072;
        f32x4 v[4]; float ss = 0.f;
        if (layer == 1 && !isctx) {
            const u16* src = (const u16*)P.out + (size_t)row * DM;
#pragma unroll
            for (int i = 0; i < 2; ++i) {
                const bf16x8 t = ld8(src + i * 512 + lane * 8);
#pragma unroll
                for (int j = 0; j < 4; ++j) { v[2 * i][j] = bf2f_s(t[j]); v[2 * i + 1][j] = bf2f_s(t[4 + j]); }
            }
        } else {
            const float* src = layer == 0 ? (isctx ? P.ctx + (size_t)(row - NLAT) * DM : P.x + (size_t)row * DM) : (const float*)(P.ws + WS_HC) + (size_t)(row - NLAT) * DM;
#pragma unroll
            for (int i = 0; i < 2; ++i) { v[2 * i] = *(const f32x4*)(src + i * 512 + lane * 8); v[2 * i + 1] = *(const f32x4*)(src + i * 512 + lane * 8 + 4); }
        }
#pragma unroll
        for (int i = 0; i < 4; ++i) ss += v[i][0] * v[i][0] + v[i][1] * v[i][1] + v[i][2] * v[i][2] + v[i][3] * v[i][3];
#pragma unroll
        for (int o = 32; o >= 1; o >>= 1) ss += __shfl_xor(ss, o);
        const float rstd = rsqrtf(ss * (1.0f / DM) + EPSV);
#pragma unroll
        for (int i = 0; i < 2; ++i) {
            const int c0 = i * 512 + lane * 8;
            float y[8];
#pragma unroll
            for (int h2 = 0; h2 < 2; ++h2) {
                const f32x4 gg = *(const f32x4*)(g + c0 + 4 * h2), sh = *(const f32x4*)(md + c0 + 4 * h2), sc = *(const f32x4*)(md + 1024 + c0 + 4 * h2);
#pragma unroll
                for (int j = 0; j < 4; ++j) y[4 * h2 + j] = v[2 * i + h2][j] * rstd * gg[j] * (1.0f + sc[j]) + sh[j];
            }
            *(bf16x8*)(A + (size_t)row * DM + c0) = pack8(y[0], y[1], y[2], y[3], y[4], y[5], y[6], y[7]);
        }
    }
}

template <int DIR, bool DRY>
DI void hg_sweep2(const Params& P, u16* Z, int it, int row0, const float (&fv)[64], float P1, float P2, const u16* Qs, u16* KdT) {
    unsigned char* dummy = P.ws + WS_HC + (size_t)blockIdx.x * 16384;
    const int tid = tidx(), ch = tid & 255, h = ch >> 6, k = ch & 63;
    u16* km_out = Z + (size_t)row0 * INC + (DIR ? C_HF1 : C_HF0) + ch;
    u16* qm_out = Z + (size_t)row0 * INC + (DIR ? C_HI : C_CB) + ch;
    u16* kd = KdT + ((DIR * 4 + h) * 64 + k) * 72;
    const float kdscale = P2;
    float eq = __builtin_amdgcn_rcpf(P1);
#pragma unroll
    for (int g = 0; g < 8; ++g) {
        float kdv[8];
#pragma unroll
        for (int jj = 0; jj < 8; ++jj) {
            const int i = 8 * g + jj, s = DIR ? 63 - i : i;
            eq *= fv[i];
            const float kk = 1.0f - fv[i];
            const float q = bf2f(Qs[s * 264 + ch]);
            const float qv = q * __builtin_amdgcn_rcpf(1.0f + __expf(-q));
            const float km = kk * __builtin_amdgcn_rcpf(eq);
            *ST(&qm_out[(size_t)s * INC]) = f2bf(qv * eq);
            *ST(&km_out[(size_t)s * INC]) = f2bf(km);
            kdv[DIR ? 7 - jj : jj] = km * kdscale;
        }
        const int s0 = DIR ? 56 - 8 * g : 8 * g;
        *(bf16x8*)(kd + s0) = pack8(kdv[0], kdv[1], kdv[2], kdv[3], kdv[4], kdv[5], kdv[6], kdv[7]);
    }
    const size_t base = ((size_t)it * 4 + h) * 2 + DIR;
    *ST(&((float*)(P.ws + WS_DEC))[base * 64 + k]) = P1 * P2;
    *ST(&((float*)(P.ws + WS_EREF))[base * 64 + k]) = P1;
}

template <int MASK, bool DRY = false>
DI void phase_c_item(const Params& P, int layer, int it, unsigned char* lds) {
    unsigned char* dummy = P.ws + WS_HC + (size_t)blockIdx.x * 16384;
    const int tid = tidx(), lane = tid & 63, wave = tid >> 6, l32 = lane & 31, hh = lane >> 5;
    const int row0 = it * 64;
    const bool isctx = it >= 512;
    const int b = isctx ? (it - 512) >> 2 : it >> 6;
    const int c = isctx ? (it - 512) & 3 : it & 63;
    const int seqlen = isctx ? CTXL : SEQ;
    u16* Z = (u16*)(P.ws + WS_Z);
    u16* Y = (u16*)(P.ws + WS_Y);
    const bool ctx_out = !(isctx && layer == 1);
    if ((MASK & 1) && ctx_out) {
        const float* cw = P.conv_w + layer * 3 * 256;
        const int c8 = (tid & 31) * 8;
        float w0[8], w1[8], w2[8];
#pragma unroll
        for (int j = 0; j < 8; ++j) { w0[j] = cw[c8 + j]; w1[j] = cw[256 + c8 + j]; w2[j] = cw[512 + c8 + j]; }
#pragma unroll 1
        for (int i = 0; i < 2; ++i) {
            bf16x8 vb[2], vc[2], vx[2], vz[2], pc[2], px[2], nc[2], nx[2];
#pragma unroll
            for (int q = 0; q < 2; ++q) {
                const int t = (tid >> 5) + 16 * (2 * i + q), tok = c * 64 + t;
                const u16* zr = Z + (size_t)(row0 + t) * INC + c8;
                const u16* zp = tok > 0 ? zr - INC : zr; const u16* zn = tok < seqlen - 1 ? zr + INC : zr;
                vb[q] = ld8(zr + C_CB); vc[q] = ld8(zr + C_CC); vx[q] = ld8(zr + C_CX); vz[q] = ld8(zr + C_CZ);
                pc[q] = ld8(zp + C_CC); px[q] = ld8(zp + C_CX); nc[q] = ld8(zn + C_CC); nx[q] = ld8(zn + C_CX);
            }
#pragma unroll
            for (int q = 0; q < 2; ++q) {
                const int t = (tid >> 5) + 16 * (2 * i + q), tok = c * 64 + t;
                const float mp = tok > 0 ? 1.0f : 0.0f, mn = tok < seqlen - 1 ? 1.0f : 0.0f;
                float y[8];
#pragma unroll
                for (int j = 0; j < 8; ++j) {
                    const float cv = mp * w0[j] * (bf2f_s(pc[q][j]) * bf2f_s(px[q][j])) + w1[j] * (bf2f_s(vc[q][j]) * bf2f_s(vx[q][j])) + mn * w2[j] * (bf2f_s(nc[q][j]) * bf2f_s(nx[q][j]));
                    y[j] = bf2f_s(vb[q][j]) * cv * silu_f(bf2f_s(vz[q][j]));
                }
                *ST((bf16x8*)(Y + (size_t)(row0 + t) * DM + c8)) = pack8(y[0], y[1], y[2], y[3], y[4], y[5], y[6], y[7]);
            }
        }
    }
    if (MASK & 2) {
        const int t = tid >> 3, dg = tid & 7;
        const size_t r = (size_t)(row0 + t);
        const float* rp = (const float*)(P.ws + WS_ROPE) + (((dg < 4 ? c : t) * 16 + (dg & 3) * 4) * 2);
        bf16x8 xv[6];
#pragma unroll
        for (int hs = 0; hs < 6; ++hs) xv[hs] = ld8(Z + r * INC + (hs < 4 ? C_AQ + hs * 64 : C_AK + (hs - 4) * 64) + dg * 8);
        const int rowi = tid >> 2, seg = tid & 3, hkv = rowi >> 6, d = rowi & 63;
        float vv[16];
#pragma unroll
        for (int j = 0; j < 16; ++j) vv[j] = bf2f(Z[(size_t)(row0 + seg * 16 + j) * INC + C_AV + hkv * 64 + d]);
        float rc[4], rs[4];
#pragma unroll
        for (int jj = 0; jj < 4; ++jj) { rc[jj] = isctx ? 1.0f : rp[2 * jj]; rs[jj] = isctx ? 0.0f : rp[2 * jj + 1]; }
#pragma unroll
        for (int hs = 0; hs < 6; ++hs) {
            const float* gain = (hs < 4 ? P.q_g : P.k_g) + layer * 64 + dg * 8;
            u16* p = Z + r * INC + (hs < 4 ? C_AQ + hs * 64 : C_AK + (hs - 4) * 64) + dg * 8;
            float x[8]; float ss = 0.f;
#pragma unroll
            for (int j = 0; j < 8; ++j) { x[j] = bf2f_s(xv[hs][j]); ss += x[j] * x[j]; }
            ss += __shfl_xor(ss, 1); ss += __shfl_xor(ss, 2); ss += __shfl_xor(ss, 4);
            const float rstd = rsqrtf(ss * (1.0f / 64.0f) + EPSV) * (hs < 4 ? QSCALE : 1.0f);
#pragma unroll
            for (int j = 0; j < 8; ++j) x[j] = x[j] * rstd * gain[j];
#pragma unroll
            for (int jj = 0; jj < 4; ++jj) {
                const float x1 = x[2 * jj], x2 = x[2 * jj + 1];
                x[2 * jj] = x1 * rc[jj] - x2 * rs[jj]; x[2 * jj + 1] = x1 * rs[jj] + x2 * rc[jj];
            }
            *ST((bf16x8*)p) = pack8(x[0], x[1], x[2], x[3], x[4], x[5], x[6], x[7]);
        }
        u16* dst = (u16*)(P.ws + WS_VT) + ((size_t)(b * 2 + hkv) * 64 + d) * NKEY + (isctx ? SEQ : 0) + c * 64 + seg * 16;
        *ST((bf16x8*)dst) = pack8(vv[0], vv[1], vv[2], vv[3], vv[8], vv[9], vv[10], vv[11]);
        *ST((bf16x8*)(dst + 8)) = pack8(vv[4], vv[5], vv[6], vv[7], vv[12], vv[13], vv[14], vv[15]);
    }
    if (MASK & 4) {
        float* ctab = (float*)lds;
        if (tid < 128) { const int m = tid & 63; ctab[tid] = tid < 64 ? cospif((float)m * (1.0f / 32.0f)) : sinpif((float)m * (1.0f / 32.0f)); }
        __syncthreads();
        const bool do_mix = isctx ? ctx_out : c < 32;
        if (!isctx && c == 32 && tid < 256) {
            const int g = tid >> 6, cp = tid & 63; float e = 0.f;
            bf16x8 uv[8];
#pragma unroll
            for (int i = 0; i < 8; ++i) uv[i] = ld8(Z + (size_t)row0 * INC + C_FU + g * 64 + 8 * i);
#pragma unroll
            for (int i = 0; i < 8; ++i)
#pragma unroll
                for (int j = 0; j < 8; ++j) e += bf2f_s(uv[i][j]) * ctab[((8 * i + j) * cp) & 63];
            *ST(&((float*)(P.ws + WS_E))[b * 256 + tid]) = e;
        }
        if (do_mix) {
        const int g = wave >> 1, trig = wave & 1;
        const float* tab = ctab + trig * 64;
        f32x16 acc[2][2];
#pragma unroll
        for (int i = 0; i < 2; ++i)
#pragma unroll
            for (int j = 0; j < 2; ++j) acc[i][j] = zero16();
#pragma unroll
        for (int ks = 0; ks < 4; ++ks) {
            bf16x8 bfr[2];
#pragma unroll
            for (int nt = 0; nt < 2; ++nt) {
                const int tl = 32 * nt + l32;
                bf16x8 a = ld8(Z + (size_t)(row0 + tl) * INC + C_FU + g * 64 + 16 * ks + 8 * hh);
                if (!isctx) {
                    const int t = c * 64 + tl;
                    const bf16x8 m = ld8(Z + (size_t)(b * SEQ + (t > 0 ? SEQ - t : 0)) * INC + C_FU + g * 64 + 16 * ks + 8 * hh);
                    const float sgn = t > 0 ? (trig ? -1.0f : 1.0f) : 0.0f;
                    a = pack8(bf2f_s(a[0]) + sgn * bf2f_s(m[0]), bf2f_s(a[1]) + sgn * bf2f_s(m[1]), bf2f_s(a[2]) + sgn * bf2f_s(m[2]), bf2f_s(a[3]) + sgn * bf2f_s(m[3]),
                              bf2f_s(a[4]) + sgn * bf2f_s(m[4]), bf2f_s(a[5]) + sgn * bf2f_s(m[5]), bf2f_s(a[6]) + sgn * bf2f_s(m[6]), bf2f_s(a[7]) + sgn * bf2f_s(m[7]));
                }
                bfr[nt] = a;
            }
#pragma unroll
            for (int mt = 0; mt < 2; ++mt) {
                const int cp = 32 * mt + l32;
                float av[8];
#pragma unroll
                for (int j = 0; j < 8; ++j) av[j] = tab[((16 * ks + 8 * hh + j) * cp) & 63];
                const bf16x8 af = pack8(av[0], av[1], av[2], av[3], av[4], av[5], av[6], av[7]);
#pragma unroll
                for (int nt = 0; nt < 2; ++nt) acc[mt][nt] = MFMA32(af, bfr[nt], acc[mt][nt]);
            }
        }
        u16* stg = (u16*)(lds + 1024 + wave * 9216);
#pragma unroll
        for (int mt = 0; mt < 2; ++mt)
#pragma unroll
            for (int nt = 0; nt < 2; ++nt)
#pragma unroll
                for (int j = 0; j < 16; ++j) stg[(32 * mt + crow(j, hh)) * 72 + 32 * nt + l32] = f2bf(acc[mt][nt][j]);
        __syncthreads();
        const int krow = isctx ? FKC : FK;
        u16* dst = (isctx ? (u16*)(P.ws + WS_UTC) : (u16*)(P.ws + WS_UT)) + (size_t)(b * 256 + g * 64) * krow + (trig ? (isctx ? CTXL : FK / 2) : 0) + c * 64;
        const int seg = (lane & 7) * 8;
        u16* dp = dst + (size_t)(lane >> 3) * krow + seg;
        const u16* sp = stg + (lane >> 3) * 72 + seg;
#pragma unroll 1
        for (int i = 0; i < 8; ++i) { *ST((bf16x8*)dp) = *(const bf16x8*)sp; dp += (size_t)8 * krow; sp += 8 * 72; }
        }
    }
    __syncthreads();
    if (MASK & 8) {
        u16* VtL = (u16*)lds;
        u16* KdT = (u16*)(lds + 36864);
        u16* Qs = (u16*)(lds + 110592);
        {
            const int dir = tid >> 8, ch = tid & 255;
            bf16x8 qp[4];
#pragma unroll
            for (int i = 0; i < 4; ++i) { const int p = tid + 512 * i; qp[i] = ld8(Z + (size_t)(row0 + (p >> 5)) * INC + C_HQ + (p & 31) * 8); }
            float vv[32];
#pragma unroll
            for (int j = 0; j < 32; ++j) vv[j] = bf2f(Z[(size_t)(row0 + 32 * dir + j) * INC + C_HI + ch]);
            float lfv[64];
            {
                const u16* fcol = Z + (size_t)row0 * INC + (dir ? C_HF1 : C_HF0) + ch;
#pragma unroll
                for (int i = 0; i < 64; ++i) lfv[i] = bf2f(fcol[(size_t)(dir ? 63 - i : i) * INC]);
            }
#pragma unroll
            for (int i = 0; i < 4; ++i) { const int p = tid + 512 * i; *(bf16x8*)(Qs + (p >> 5) * 264 + (p & 31) * 8) = qp[i]; }
            {
                u16* gl = (u16*)(P.ws + WS_VTH) + ((size_t)it * 256 + ch) * 64 + 32 * dir;
                u16* ll = VtL + ch * 72 + 32 * dir;
#pragma unroll
                for (int q = 0; q < 4; ++q) {
                    const bf16x8 w = pack8(vv[8 * q], vv[8 * q + 1], vv[8 * q + 2], vv[8 * q + 3], vv[8 * q + 4], vv[8 * q + 5], vv[8 * q + 6], vv[8 * q + 7]);
                    *ST((bf16x8*)(gl + 8 * q)) = w; *(bf16x8*)(ll + 8 * q) = w;
                }
            }
            float lb = 0.f;
            if (layer > 0) { const float l0 = P.hgrn_lb[(dir * 2 + 0) * 256 + ch], l1 = P.hgrn_lb[(dir * 2 + 1) * 256 + ch]; lb = 1.0f / (1.0f + __expf(l0 - l1)); }
            const float oml = 1.0f - lb;
            float P1 = 1.0f, P2 = 1.0f;
#pragma unroll
            for (int i = 0; i < 64; ++i) {
                lfv[i] = lb + oml * __builtin_amdgcn_rcpf(1.0f + __expf(-lfv[i]));
                if (i < 32) P1 *= lfv[i]; else P2 *= lfv[i];
            }
            __syncthreads();
            if (dir == 0) hg_sweep2<0, DRY>(P, Z, it, row0, lfv, P1, P2, Qs, KdT); else hg_sweep2<1, DRY>(P, Z, it, row0, lfv, P1, P2, Qs, KdT);
        }
        __syncthreads();
        {
            const int h = wave & 3, dir = wave >> 2;
            f32x16 acc[2][2];
#pragma unroll
            for (int i = 0; i < 2; ++i)
#pragma unroll
                for (int j = 0; j < 2; ++j) acc[i][j] = zero16();
#pragma unroll
            for (int ks = 0; ks < 4; ++ks) {
                bf16x8 af[2], bfr[2];
#pragma unroll
                for (int mt = 0; mt < 2; ++mt) af[mt] = *(const bf16x8*)(VtL + (h * 64 + 32 * mt + l32) * 72 + 16 * ks + 8 * hh);
#pragma unroll
                for (int nt = 0; nt < 2; ++nt) bfr[nt] = *(const bf16x8*)(KdT + ((dir * 4 + h) * 64 + 32 * nt + l32) * 72 + 16 * ks + 8 * hh);
#pragma unroll
                for (int mt = 0; mt < 2; ++mt)
#pragma unroll
                    for (int nt = 0; nt < 2; ++nt) acc[mt][nt] = MFMA32(af[mt], bfr[nt], acc[mt][nt]);
            }
            u16* dst = (u16*)(P.ws + WS_G) + (((size_t)it * 4 + h) * 2 + dir) * 4096;
#pragma unroll
            for (int mt = 0; mt < 2; ++mt)
#pragma unroll
                for (int nt = 0; nt < 2; ++nt)
#pragma unroll
                    for (int j = 0; j < 16; ++j) *ST(&dst[(32 * mt + crow(j, hh)) * 64 + 32 * nt + l32]) = f2bf(acc[mt][nt][j]);
        }
        __syncthreads();
    }
}

template <bool DRY>
DI void hg_scan_item(const Params& P, int it) {
    unsigned char* dummy = P.ws + WS_HC + (size_t)blockIdx.x * 16384;
    const int tid = tidx();
    const int b = it >> 3, h = (it >> 1) & 3, dir = it & 1;
    const int k0 = (tid & 7) * 8;
    float S[8];
#pragma unroll
    for (int j = 0; j < 8; ++j) S[j] = 0.f;
    u16* G = (u16*)(P.ws + WS_G);
    const float* dec = (const float*)(P.ws + WS_DEC);
    const float* eref = (const float*)(P.ws + WS_EREF);
#pragma unroll 1
    for (int j0 = 0; j0 < 68; j0 += 4) {
        u16* gp[4]; bf16x8 g[4]; f32x4 dc[4][2], er[4][2];
#pragma unroll
        for (int q = 0; q < 4; ++q) {
            const int j = j0 + q;
            const int ci = dir == 0 ? (j < 4 ? 512 + 4 * b + j : 64 * b + j - 4) : (j < 4 ? 512 + 4 * b + 3 - j : 64 * b + 67 - j);
            const size_t base = ((size_t)ci * 4 + h) * 2 + dir;
            gp[q] = G + base * 4096 + tid * 8;
            g[q] = ld8(gp[q]);
            dc[q][0] = *(const f32x4*)(dec + base * 64 + k0); dc[q][1] = *(const f32x4*)(dec + base * 64 + k0 + 4);
            er[q][0] = *(const f32x4*)(eref + base * 64 + k0); er[q][1] = *(const f32x4*)(eref + base * 64 + k0 + 4);
        }
        asm volatile("" ::: "memory");
#pragma unroll
        for (int q = 0; q < 4; ++q) {
            float o[8];
#pragma unroll
            for (int j = 0; j < 8; ++j) { o[j] = S[j] * er[q][j >> 2][j & 3]; S[j] = dc[q][j >> 2][j & 3] * S[j] + bf2f_s(g[q][j]); }
            u16* gq = gp[q];
            *ST((bf16x8*)gq) = pack8(o[0], o[1], o[2], o[3], o[4], o[5], o[6], o[7]);
        }
    }
}

DI void attn_item(const Params& P, int layer, int item, unsigned char* lds) {
    const int tid = tidx(), lane = tid & 63, wave = tid >> 6, l32 = lane & 31, hh = lane >> 5;
    int b, hkv, qrow0, t_lo;
    if (item < 512) { b = item >> 6; hkv = (item >> 5) & 1; qrow0 = b * SEQ + (item & 31) * 128; t_lo = 0; }
    else { const int j = item - 512; b = j >> 2; hkv = (j >> 1) & 1; qrow0 = NLAT + b * CTXL + (j & 1) * 128; t_lo = 64; }
    const int t_hi = 68;
    const u16* Z = (const u16*)(P.ws + WS_Z);
    const u16* Vt = (const u16*)(P.ws + WS_VT) + (size_t)(b * 2 + hkv) * 64 * NKEY;
    const int hq = hkv * 2 + (wave >> 2);
    const size_t qrow = (size_t)(qrow0 + (wave & 3) * 32 + l32);
    float mshift;
    {
        float gq = fabsf(P.q_g[layer * 64 + lane]), gk = fabsf(P.k_g[layer * 64 + lane]);
#pragma unroll
        for (int o = 32; o >= 1; o >>= 1) { gq = fmaxf(gq, __shfl_xor(gq, o)); gk = fmaxf(gk, __shfl_xor(gk, o)); }
        const float bound = QSCALE * 64.0f * gq * gk;
        mshift = bound > 60.0f ? bound : 0.0f;
    }
    const f32x16 cinit = zero16();
    bf16x8 Qf[4];
#pragma unroll
    for (int ks = 0; ks < 4; ++ks) Qf[ks] = ld8(Z + qrow * INC + C_AQ + hq * 64 + 16 * ks + 8 * hh);
    const int lr = tid >> 3, lseg = (tid & 7) * 8;
    auto krow_of = [&](int t) { return t < 64 ? b * SEQ + 64 * t : NLAT + b * CTXL + 64 * (t - 64); };
    const int NP = (t_hi - t_lo) >> 1;
    bf16x8 kreg[2], vreg[2];
#define ATT_GLOAD(pp) do { _Pragma("unroll") for (int u = 0; u < 2; ++u) { const int tt = t_lo + 2 * (pp) + u; \
        kreg[u] = ld8(Z + (size_t)(krow_of(tt) + lr) * INC + C_AK + hkv * 64 + lseg); vreg[u] = ld8(Vt + (size_t)lr * NKEY + 64 * tt + lseg); } } while (0)
#define ATT_LWRITE(pp) do { unsigned char* bb = lds + ((pp) % 3) * 36864; _Pragma("unroll") for (int u = 0; u < 2; ++u) { \
        *(bf16x8*)((u16*)(bb + u * 18432) + lr * 72 + lseg) = kreg[u]; *(bf16x8*)((u16*)(bb + u * 18432 + 9216) + lr * 72 + lseg) = vreg[u]; } } while (0)
#define ATT_LDK(Ks) do { _Pragma("unroll") for (int mt = 0; mt < 2; ++mt) _Pragma("unroll") for (int ks = 0; ks < 4; ++ks) fr[mt * 4 + ks] = *(const bf16x8*)((Ks) + (32 * mt + l32) * 72 + 16 * ks + 8 * hh); } while (0)
#define ATT_LDV(Vs) do { _Pragma("unroll") for (int s4 = 0; s4 < 4; ++s4) _Pragma("unroll") for (int mo = 0; mo < 2; ++mo) fr[s4 * 2 + mo] = *(const bf16x8*)((Vs) + (32 * mo + l32) * 72 + 16 * s4 + 8 * hh); } while (0)
#define ATT_QK(dst) do { _Pragma("unroll") for (int mt = 0; mt < 2; ++mt) { dst[mt] = MFMA32(fr[mt * 4], Qf[0], cinit); \
        _Pragma("unroll") for (int ks = 1; ks < 4; ++ks) dst[mt] = MFMA32(fr[mt * 4 + ks], Qf[ks], dst[mt]); } } while (0)
#define ATT_SOFT_PV(sv) do { float rs0 = 0.f, rs1 = 0.f; \
        if (mshift != 0.f) { _Pragma("unroll") for (int mt = 0; mt < 2; ++mt) _Pragma("unroll") for (int j = 0; j < 16; ++j) sv[mt][j] -= mshift; } \
        _Pragma("unroll") for (int mt = 0; mt < 2; ++mt) _Pragma("unroll") for (int j = 0; j < 16; j += 2) { \
            const float p0 = __builtin_amdgcn_exp2f(sv[mt][j]), p1 = __builtin_amdgcn_exp2f(sv[mt][j + 1]); sv[mt][j] = p0; sv[mt][j + 1] = p1; rs0 += p0; rs1 += p1; } \
        l_run += rs0 + rs1; \
        _Pragma("unroll") for (int s4 = 0; s4 < 4; ++s4) { const int mt = s4 >> 1, s = s4 & 1; \
            const bf16x8 pf = pack8(sv[mt][8 * s], sv[mt][8 * s + 1], sv[mt][8 * s + 2], sv[mt][8 * s + 3], sv[mt][8 * s + 4], sv[mt][8 * s + 5], sv[mt][8 * s + 6], sv[mt][8 * s + 7]); \
            _Pragma("unroll") for (int mo = 0; mo < 2; ++mo) oT[mo] = MFMA32(fr[s4 * 2 + mo], pf, oT[mo]); } } while (0)
#define ATT_SB __builtin_amdgcn_sched_barrier(0)
    ATT_GLOAD(0);
    __syncthreads();
    ATT_LWRITE(0);
    if (NP > 1) ATT_GLOAD(1);
    __syncthreads();
    f32x16 oT[2]; oT[0] = zero16(); oT[1] = zero16();
    float l_run = 0.f;
    f32x16 sA[2], sB[2];
    bf16x8 fr[8];
    ATT_LDK((const u16*)lds);
    ATT_QK(sA);
#pragma unroll 1
    for (int p = 0; p < NP; ++p) {
        const unsigned char* cb = lds + (p % 3) * 36864;
        const unsigned char* nb = lds + ((p + 1) % 3) * 36864;
        ATT_LDK((const u16*)(cb + 18432));
        if (p + 1 < NP) ATT_LWRITE(p + 1);
        if (p + 2 < NP) ATT_GLOAD(p + 2);
        ATT_SB;
        ATT_QK(sB);
        ATT_SB;
        ATT_LDV((const u16*)(cb + 9216));
        ATT_SB;
        ATT_SOFT_PV(sA);
        ATT_SB;
        __syncthreads();
        if (p + 1 < NP) {
            ATT_LDK((const u16*)nb);
            ATT_SB;
            ATT_QK(sA);
            ATT_SB;
        }
        ATT_LDV((const u16*)(cb + 18432 + 9216));
        ATT_SB;
        ATT_SOFT_PV(sB);
        ATT_SB;
    }
#undef ATT_GLOAD
#undef ATT_LWRITE
#undef ATT_LDK
#undef ATT_LDV
#undef ATT_QK
#undef ATT_SOFT_PV
#undef ATT_SB
    s16x4 azv[2][4];
#pragma unroll
    for (int mo = 0; mo < 2; ++mo)
#pragma unroll
        for (int g4 = 0; g4 < 4; ++g4) azv[mo][g4] = ld4(Z + qrow * INC + C_AZ + hq * 64 + 32 * mo + 8 * g4 + 4 * hh);
    const float l_tot = l_run + __shfl_xor(l_run, 32);
    const float inv = 1.0f / l_tot;
    u16* Y = (u16*)(P.ws + WS_Y);
#pragma unroll
    for (int mo = 0; mo < 2; ++mo)
#pragma unroll
        for (int g4 = 0; g4 < 4; ++g4) {
            const int d0 = 32 * mo + 8 * g4 + 4 * hh;
            const s16x4 az = azv[mo][g4];
            u32x2 w;
            w.x = pack2(oT[mo][4 * g4] * inv * silu_f(bf2f_s(az[0])), oT[mo][4 * g4 + 1] * inv * silu_f(bf2f_s(az[1])));
            w.y = pack2(oT[mo][4 * g4 + 2] * inv * silu_f(bf2f_s(az[2])), oT[mo][4 * g4 + 3] * inv * silu_f(bf2f_s(az[3])));
            *(u32x2*)(Y + qrow * DM + 256 + hq * 64 + d0) = w;
        }
}

DI void hg_out_item(const Params& P, int layer, int it, unsigned char* lds) {
    const int tid = tidx(), lane = tid & 63, wave = tid >> 6, l32 = lane & 31, hh = lane >> 5;
    const int row0 = it * 64, h = wave >> 1, nt = wave & 1, t = 32 * nt + l32;
    const u16* Z = (const u16*)(P.ws + WS_Z);
    const u16* G = (const u16*)(P.ws + WS_G);
    const u16* VtH = (const u16*)(P.ws + WS_VTH) + (size_t)it * 4 * 4096;
    u16* QmL = (u16*)lds; u16* KmL = (u16*)(lds + 36864); u16* SsL = (u16*)(lds + 73728); u16* VL = (u16*)(lds + 110592);
    f32x16 oT[2]; oT[0] = zero16(); oT[1] = zero16();
    bf16x8 rq[4], rk[4], rs[4], rv[4];
#define HG_GLOAD(dir) do { const int qc = (dir) ? C_HI : C_CB, kc = (dir) ? C_HF1 : C_HF0; \
        _Pragma("unroll") for (int i = 0; i < 4; ++i) { const int p = tid + 512 * i; \
            rq[i] = ld8(Z + (size_t)(row0 + (p >> 5)) * INC + qc + (p & 31) * 8); rk[i] = ld8(Z + (size_t)(row0 + (p >> 5)) * INC + kc + (p & 31) * 8); \
            rs[i] = ld8(G + (((size_t)it * 4 + (p >> 9)) * 2 + (dir)) * 4096 + (p & 511) * 8); } } while (0)
#define HG_LWRITE() do { _Pragma("unroll") for (int i = 0; i < 4; ++i) { const int p = tid + 512 * i; \
            const int o1 = ((p & 31) >> 3) * 4608 + (p >> 5) * 72 + (p & 7) * 8; *(bf16x8*)(QmL + o1) = rq[i]; *(bf16x8*)(KmL + o1) = rk[i]; \
            *(bf16x8*)(SsL + (p >> 9) * 4608 + ((p >> 3) & 63) * 72 + (p & 7) * 8) = rs[i]; } } while (0)
    HG_GLOAD(0);
#pragma unroll
    for (int i = 0; i < 4; ++i) { const int p = tid + 512 * i; rv[i] = ld8(VtH + (size_t)p * 8); }
    __syncthreads();
    HG_LWRITE();
#pragma unroll
    for (int i = 0; i < 4; ++i) { const int p = tid + 512 * i; *(bf16x8*)(VL + (p >> 3) * 72 + (p & 7) * 8) = rv[i]; }
    HG_GLOAD(1);
    __syncthreads();
#pragma unroll
    for (int dir = 0; dir < 2; ++dir) {
        const u16* Qh = QmL + h * 4608; const u16* Kh = KmL + h * 4608; const u16* Sh = SsL + h * 4608; const u16* Vh = VL + h * 4608;
        const int mt_off = nt ^ 1;
        const bool need_off = dir == 0 ? (mt_off < nt) : (mt_off > nt);
        bf16x8 Qf[4];
#pragma unroll
        for (int ks = 0; ks < 4; ++ks) Qf[ks] = *(const bf16x8*)(Qh + t * 72 + 16 * ks + 8 * hh);
#pragma unroll
        for (int ks = 0; ks < 4; ++ks)
#pragma unroll
            for (int mo = 0; mo < 2; ++mo) oT[mo] = MFMA32(*(const bf16x8*)(Sh + (32 * mo + l32) * 72 + 16 * ks + 8 * hh), Qf[ks], oT[mo]);
        {
            f32x16 sT = zero16();
#pragma unroll
            for (int ks = 0; ks < 4; ++ks) sT = MFMA32(*(const bf16x8*)(Kh + (32 * nt + l32) * 72 + 16 * ks + 8 * hh), Qf[ks], sT);
#pragma unroll
            for (int j = 0; j < 16; ++j) { const int sl = crow(j, hh); const bool keep = dir == 0 ? (sl <= l32) : (sl >= l32); sT[j] = keep ? sT[j] : 0.f; }
#pragma unroll
            for (int s = 0; s < 2; ++s) {
                const bf16x8 pf = pack8(sT[8 * s], sT[8 * s + 1], sT[8 * s + 2], sT[8 * s + 3], sT[8 * s + 4], sT[8 * s + 5], sT[8 * s + 6], sT[8 * s + 7]);
#pragma unroll
                for (int mo = 0; mo < 2; ++mo) {
                    const u16* vp = Vh + (32 * mo + l32) * 72 + 32 * nt + 16 * s + 4 * hh;
                    oT[mo] = MFMA32(__builtin_shufflevector(*(const s16x4*)vp, *(const s16x4*)(vp + 8), 0, 1, 2, 3, 4, 5, 6, 7), pf, oT[mo]);
                }
            }
        }
        if (need_off) {
            f32x16 sT = zero16();
#pragma unroll
            for (int ks = 0; ks < 4; ++ks) sT = MFMA32(*(const bf16x8*)(Kh + (32 * mt_off + l32) * 72 + 16 * ks + 8 * hh), Qf[ks], sT);
#pragma unroll
            for (int s = 0; s < 2; ++s) {
                const bf16x8 pf = pack8(sT[8 * s], sT[8 * s + 1], sT[8 * s + 2], sT[8 * s + 3], sT[8 * s + 4], sT[8 * s + 5], sT[8 * s + 6], sT[8 * s + 7]);
#pragma unroll
                for (int mo = 0; mo < 2; ++mo) {
                    const u16* vp = Vh + (32 * mo + l32) * 72 + 32 * mt_off + 16 * s + 4 * hh;
                    oT[mo] = MFMA32(__builtin_shufflevector(*(const s16x4*)vp, *(const s16x4*)(vp + 8), 0, 1, 2, 3, 4, 5, 6, 7), pf, oT[mo]);
                }
            }
        }
        if (dir == 0) { __syncthreads(); HG_LWRITE(); __syncthreads(); }
    }
#undef HG_GLOAD
#undef HG_LWRITE
    float ss = 0.f;
#pragma unroll
    for (int mo = 0; mo < 2; ++mo)
#pragma unroll
        for (int j = 0; j < 16; ++j) ss += oT[mo][j] * oT[mo][j];
    ss += __shfl_xor(ss, 32);
    const float rstd = rsqrtf(ss * (1.0f / 64.0f) + EPSV);
    u16* Y = (u16*)(P.ws + WS_Y);
    const size_t row = (size_t)(row0 + t);
    f32x4 gnv[2][4]; s16x4 hzv[2][4];
#pragma unroll
    for (int mo = 0; mo < 2; ++mo)
#pragma unroll
        for (int g4 = 0; g4 < 4; ++g4) {
            const int v0 = 32 * mo + 8 * g4 + 4 * hh;
            gnv[mo][g4] = *(const f32x4*)(P.hg_g + layer * 256 + h * 64 + v0);
            hzv[mo][g4] = ld4(Z + row * INC + C_HZ + h * 64 + v0);
        }
#pragma unroll
    for (int mo = 0; mo < 2; ++mo)
#pragma unroll
        for (int g4 = 0; g4 < 4; ++g4) {
            const int v0 = 32 * mo + 8 * g4 + 4 * hh;
            const f32x4 gn = gnv[mo][g4]; const s16x4 hz = hzv[mo][g4];
            u32x2 w;
            w.x = pack2(oT[mo][4 * g4] * rstd * gn[0] * silu_f(bf2f_s(hz[0])), oT[mo][4 * g4 + 1] * rstd * gn[1] * silu_f(bf2f_s(hz[1])));
            w.y = pack2(oT[mo][4 * g4 + 2] * rstd * gn[2] * silu_f(bf2f_s(hz[2])), oT[mo][4 * g4 + 3] * rstd * gn[3] * silu_f(bf2f_s(hz[3])));
            *(u32x2*)(Y + row * DM + 512 + h * 64 + v0) = w;
        }
}

DI void four_row2048_item(const Params& P, int b, int j) {
    const int tid = tidx(), lane = tid & 63, wave = tid >> 6;
    const float* E = (const float*)(P.ws + WS_E) + b * 256;
    const u16* Z = (const u16*)(P.ws + WS_Z);
    u16* Y = (u16*)(P.ws + WS_Y);
    const size_t r = (size_t)(b * SEQ + 2048);
    bf16x8 v[4][4];
#pragma unroll
    for (int nn = 0; nn < 4; ++nn) {
        const u16* up = (const u16*)(P.ws + WS_UT) + (size_t)(b * 256 + j * 32 + wave * 4 + nn) * FK;
#pragma unroll
        for (int i = 0; i < 4; ++i) v[nn][i] = ld8(up + (i * 64 + lane) * 8);
    }
#pragma unroll
    for (int nn = 0; nn < 4; ++nn) {
        const int n = j * 32 + wave * 4 + nn;
        float acc = 0.f;
#pragma unroll
        for (int i = 0; i < 4; ++i) {
            const bf16x8 w = v[nn][i];
            acc += (bf2f_s(w[0]) - bf2f_s(w[1])) + (bf2f_s(w[2]) - bf2f_s(w[3])) + (bf2f_s(w[4]) - bf2f_s(w[5])) + (bf2f_s(w[6]) - bf2f_s(w[7]));
        }
#pragma unroll
        for (int o = 32; o >= 1; o >>= 1) acc += __shfl_xor(acc, o);
        if (lane == 0) Y[r * DM + 768 + n] = f2bf((acc + E[n]) * (1.0f / 512.0f) * silu_f(bf2f(Z[r * INC + C_FZ + n])));
    }
}

DI void ctx_outproj(const Params& P, int G, int bx) {
    const int tid = tidx(), lane = tid & 63, wave = tid >> 6, l32 = lane & 31, hh = lane >> 5;
    const u16* Y = (const u16*)(P.ws + WS_Y);
    const u16* Wt = (const u16*)(P.ws + WS_WOUT);
    const float* gate = (const float*)(P.ws + WS_MOD) + 8 * 3072 + 2048;
    float* hc = (float*)(P.ws + WS_HC);
#pragma unroll 1
    for (int tile = bx; tile < 256; tile += G) {
        const int rb = tile >> 3, cb = tile & 7, r0 = rb * 64 + (wave >> 2) * 32, c0 = cb * 128 + (wave & 3) * 32;
        const u16* ap = Y + (size_t)(NLAT + r0 + l32) * DM + 8 * hh;
        const u16* bp = Wt + (size_t)(c0 + l32) * DM + 8 * hh;
        f32x16 acc = zero16();
#pragma unroll 1
        for (int k0 = 0; k0 < 64; k0 += 8) {
            bf16x8 af[8], bfg[8];
#pragma unroll
            for (int j = 0; j < 8; ++j) { af[j] = ld8(ap + 16 * (k0 + j)); bfg[j] = ld8(bp + 16 * (k0 + j)); }
            asm volatile("" ::: "memory");
#pragma unroll
            for (int j = 0; j < 8; ++j) acc = MFMA32(af[j], bfg[j], acc);
        }
        const float gv = gate[c0 + l32];
        float res[16];
#pragma unroll
        for (int j = 0; j < 16; ++j) res[j] = P.ctx[(size_t)(r0 + crow(j, hh)) * DM + c0 + l32];
#pragma unroll
        for (int j = 0; j < 16; ++j) hc[(size_t)(r0 + crow(j, hh)) * DM + c0 + l32] = res[j] + gv * acc[j];
    }
}

DI void phase_g(const Params& P) {
    const int tid_ = tidx(); const int lane = tid_ & 63, wave = tid_ >> 6;
    const u16* H2 = (const u16*)(P.ws + WS_Z);
    for (int row = blockIdx.x * 8 + wave; row < NLAT; row += gridDim.x * 8) {
        const u16* src = H2 + (size_t)row * DM;
        float* p = P.out + (size_t)row * DM;
        f32x4 v[4]; float ss = 0.f;
#pragma unroll
        for (int i = 0; i < 2; ++i) {
            const bf16x8 t = ld8(src + i * 512 + lane * 8);
#pragma unroll
            for (int j = 0; j < 4; ++j) { v[2 * i][j] = bf2f_s(t[j]); v[2 * i + 1][j] = bf2f_s(t[4 + j]); }
        }
#pragma unroll
        for (int i = 0; i < 4; ++i) ss += v[i][0] * v[i][0] + v[i][1] * v[i][1] + v[i][2] * v[i][2] + v[i][3] * v[i][3];
#pragma unroll
        for (int o = 32; o >= 1; o >>= 1) ss += __shfl_xor(ss, o);
        const float rstd = rsqrtf(ss * (1.0f / DM) + EPSV);
#pragma unroll
        for (int i = 0; i < 2; ++i)
#pragma unroll
            for (int h2 = 0; h2 < 2; ++h2) {
                const int c0 = i * 512 + lane * 8 + 4 * h2;
                const f32x4 gg = *(const f32x4*)(P.final_g + c0);
                *(f32x4*)(p + c0) = v[2 * i + h2] * rstd * gg;
            }
    }
}

__global__ void __launch_bounds__(512, 2) fwd_megakernel(Params P) {
    extern __shared__ __attribute__((aligned(16))) unsigned char lds[];
    cg::grid_group grid = cg::this_grid();
    PG8_LAS unsigned char* lds3 = (PG8_LAS unsigned char*)lds;
    const int lo = P.ph_lo, hi = P.ph_hi;
    if (lo < 0) grid.sync();
    const int G = gridDim.x, bx = blockIdx.x;
#define IN(k) (lo <= (k) && (k) < hi)
    volatile LAS unsigned* xst = (volatile LAS unsigned*)(lds3 + LDS_CTL + 64);
    if (threadIdx.x == 0) { xst[0] = 0u; xst[1] = 0u; }
    __syncthreads();
    XcdBarrier xbar; xbar.bar = (unsigned*)(P.ws + WS_BAR); xbar.x = 0; xbar.st = xst;
    if (!MK_PER_PHASE) xbar = xcd_barrier_post((unsigned*)(P.ws + WS_BAR), xst);
#define SEAM(k) do { if (!MK_PER_PHASE && IN(k) && IN((k) + 1)) { xcd_barrier(xbar); } } while (0)
    if (IN(0)) {
        const Params Q = launder(P);
        p0_prologue(Q, lds, 0, P0_WIN0, bx, G);
        p0_prologue(Q, lds, P0_CS, P0_END, bx, G);
    }
    SEAM(0);
#pragma unroll 1
    for (int layer_ = 0; layer_ < 2; ++layer_) {
        int layer = layer_; asm volatile("" : "+s"(layer));
        const int pb = 1 + 6 * layer_;
        if (IN(pb + 0)) { const Params Q = launder(P); phase_a(Q, layer); }
        SEAM(pb + 0);
        if (IN(pb + 1)) {
            const Params Q = launder(P); u16* Z = (u16*)(Q.ws + WS_Z);
            pg8::Gemm g{(const u16*)(Q.ws + WS_Y), (const u16*)(Q.ws + WS_WIN) + (size_t)layer * INC * DM, NROW, INC, DM};
            pg8::StaticOrder S; S.init(NROW, INC, G, bx);
            pg8::EpiBf16<0> E{Z, INC, nullptr, 0, 0};
            pg8::gemm_phase<pg8::EpiBf16<0>, pg8::StaticOrder>(lds3, g, S, E);
            if (layer == 0) {
                const int nfull = (NROW / 256) * (INC / 256) % G;
                __syncthreads();
                if (bx >= nfull) p0_prologue(Q, lds, P0_WIN0, P0_WOUT, bx - nfull, G - nfull);
            }
        }
        SEAM(pb + 1);
        if (IN(pb + 2)) {
            const Params Q = launder(P);
#pragma unroll 1
            for (int it = bx; it < NCHUNK; it += G) phase_c_item<15>(Q, layer, it, lds);
            if (layer == 0) {
                const int nfull = NCHUNK % G;
                __syncthreads();
                if (bx >= nfull) p0_prologue(Q, lds, P0_WOUT, P0_CS, bx - nfull, G - nfull);
            }
        }
        SEAM(pb + 2);
        if (IN(pb + 3)) {
            const Params Q = launder(P); u16* Z = (u16*)(Q.ws + WS_Z); u16* Y = (u16*)(Q.ws + WS_Y);
#pragma unroll 1
            for (int it = (bx + G - G / 2) % G; it < 64; it += G) hg_scan_item<false>(Q, it);
            unsigned* scan_done = (unsigned*)(Q.ws + WS_CTR) + layer * 256 + 200;
            __threadfence(); __syncthreads();
            if (tidx() == 0) __hip_atomic_fetch_add(scan_done, 1u, __ATOMIC_RELAXED, __HIP_MEMORY_SCOPE_AGENT);
            { const int rep = 0;
            {
                pg8::Gemm g{(const u16*)(Q.ws + WS_CS), (const u16*)(Q.ws + WS_UT), SEQ / 2, 2048, FK};
                pg8::StaticOrder S; S.init(SEQ / 2, 2048, G, bx);
                EpiFourM E{Z, Y, 1.0f / 512.0f, (const float*)(Q.ws + WS_E), (f32x4*)(Q.ws + WS_STASH) + (size_t)(bx & 63) * 16384};
                pg8::gemm_phase<EpiFourM, pg8::StaticOrder>(lds3, g, S, E);
            }
            if (layer == 0) {
                pg8::Gemm g{(const u16*)(Q.ws + WS_CSC), (const u16*)(Q.ws + WS_UTC), CTXL, 2048, FKC};
                pg8::StaticOrder S; S.init(CTXL, 2048, G, (bx + G - 128) % G);
                EpiFour E{Z, Y, 1, 1.0f / 128.0f, nullptr};
                pg8::gemm_phase<EpiFour, pg8::StaticOrder>(lds3, g, S, E);
            }
            __syncthreads();
            {
                const int xq = bx & 7;
                unsigned* ctr = (unsigned*)(Q.ws + WS_CTR) + layer * 256 + xq * 16 + rep * 128;
                volatile int* slot = (volatile int*)(lds + LDS_CTL);
                const int n_actx = layer == 0 ? 4 : 0, n_hctx = layer == 0 ? 4 : 0;
                const int e0 = 8, e1 = e0 + 64, e2 = e1 + n_actx, e3 = e2 + 64, e4 = e3 + n_hctx;
                bool scan_ok = false;
                for (;;) {
                    __syncthreads();
                    if (tidx() == 0) *slot = (int)atomicAdd(ctr, 1u);
                    __syncthreads();
                    const int e = *slot;
                    if (e >= e4) break;
                    if (e < e0) four_row2048_item(Q, xq, e);
                    else if (e < e2) attn_item(Q, layer, e < e1 ? 64 * xq + (e - e0) : 512 + 4 * xq + (e - e1), lds);
                    else {
                        if (!scan_ok) {
                            if (tidx() == 0) { unsigned sp = 0; while (__hip_atomic_load(scan_done, __ATOMIC_RELAXED, __HIP_MEMORY_SCOPE_AGENT) < (unsigned)G && ++sp < (1u << 22)) __builtin_amdgcn_s_sleep(2); }
                            __syncthreads();
                            __builtin_amdgcn_fence(__ATOMIC_ACQUIRE, "agent");
                            asm volatile("s_waitcnt vmcnt(0)" ::: "memory");
                            scan_ok = true;
                        }
                        hg_out_item(Q, layer, e < e3 ? 64 * xq + (e - e2) : 512 + 4 * xq + (e - e3), lds);
                    }
                }
            }
            }
        }
        SEAM(pb + 3);
        if (IN(pb + 5)) {
            const Params Q = launder(P);
            const int M = NLAT;
            pg8::Gemm g{(const u16*)(Q.ws + WS_Y), (const u16*)(Q.ws + WS_WOUT) + (size_t)layer * DM * DM, M, DM, DM};
            pg8::StaticOrder S; S.init(M, DM, G, bx);
            EpiRes E{Q.x, (const u16*)Q.out, layer == 0 ? (u16*)Q.out : (u16*)(Q.ws + WS_Z), (const float*)(Q.ws + WS_MOD) + layer * 9 * 3072, layer == 0 ? 0 : 1};
            pg8::gemm_phase<EpiRes, pg8::StaticOrder>(lds3, g, S, E);
            if (layer == 0) ctx_outproj(Q, G, bx);
        }
        SEAM(pb + 5);
    }
    if (IN(13)) { const Params Q = launder(P); phase_g(Q); }
#undef IN
#undef SEAM
}

extern "C" void kernel_launch(void* const* d_in, const int* in_sizes, int n_in, void* d_out, int out_size, void* d_ws, size_t ws_size, hipStream_t stream) {
    static int grid = 0;
    if (grid == 0) {
        if (n_in != 15 || ws_size < WS_END) { fprintf(stderr, "kernel_launch: need 15 inputs and >= %zu bytes of workspace (got %d, %zu)\n", (size_t)WS_END, n_in, ws_size); grid = -1; return; }
        int dev = 0, cus = 0, per_cu = 0;
        (void)hipGetDevice(&dev);
        (void)hipDeviceGetAttribute(&cus, hipDeviceAttributeMultiprocessorCount, dev);
        if (hipFuncSetAttribute((const void*)fwd_megakernel, hipFuncAttributeMaxDynamicSharedMemorySize, LDS_BYTES) != hipSuccess) { fprintf(stderr, "kernel_launch: hipFuncSetAttribute failed\n"); grid = -1; return; }
        if (hipOccupancyMaxActiveBlocksPerMultiprocessor(&per_cu, (const void*)fwd_megakernel, 512, LDS_BYTES) != hipSuccess || per_cu < 1) { fprintf(stderr, "kernel_launch: occupancy query says %d blocks per CU\n", per_cu); per_cu = 1; }
        (void)hipGetLastError();
        grid = cus;
    }
    if (grid < 0) return;
    (void)hipMemsetAsync((char*)d_ws + WS_CTR, 0, WS_CTL_BYTES, stream);
    Params p{};
    p.x = (const float*)d_in[0]; p.c = (const float*)d_in[1]; p.ctx = (const float*)d_in[2]; p.c_ctx = (const float*)d_in[3]; p.norm_g = (const float*)d_in[4];
    p.w_mod = (const float*)d_in[5]; p.b_mod = (const float*)d_in[6]; p.w_in = (const float*)d_in[7]; p.conv_w = (const float*)d_in[8]; p.q_g = (const float*)d_in[9];
    p.k_g = (const float*)d_in[10]; p.hgrn_lb = (const float*)d_in[11]; p.hg_g = (const float*)d_in[12]; p.w_out = (const float*)d_in[13]; p.final_g = (const float*)d_in[14];
    p.out = (float*)d_out; p.ws = (unsigned char*)d_ws;
#if MK_PER_PHASE
    for (int ph = 0; ph < 14; ++ph) {
        p.ph_lo = ph; p.ph_hi = ph + 1;
        hipLaunchKernelGGL(fwd_megakernel, dim3(grid), dim3(512), LDS_BYTES, stream, p);
    }
#else
    p.ph_lo = 0; p.ph_hi = 14;
    void* args[] = {&p};
    hipError_t e = hipLaunchCooperativeKernel((void*)fwd_megakernel, dim3(grid), dim3(512), args, LDS_BYTES, stream);
    if (e != hipSuccess) fprintf(stderr, "cooperative launch failed: %s (grid %d)\n", hipGetErrorString(e), grid);
#endif
}
```
